# Optimizing an MI355X kernel written in HIP

```python
import jax, jax.numpy as jnp
from jax import lax
import numpy as np

D_MODEL = 1024
BATCH = 2
SEQ = 8192
DEPTH = 2

CTX_LEN = 256
GRID_W = 64
N_MOD = 6
NORM_EPS = 1e-6

ML_HEADS = 4
ML_DQK = 64
ML_DV = 128
ML_QK = ML_HEADS * ML_DQK
ML_V = ML_HEADS * ML_DV
ML_CHUNK = 64
GATE_CAP = 15.0
ML_COLS = 2 * ML_QK + 2 * ML_V + 4 * ML_HEADS

RW_HEADS = 8
RW_N = 64
RW_W = RW_HEADS * RW_N
RW_DECAY_LORA = 64
RW_A_LORA = 64
RW_GATE_LORA = 128
RW_GN_EPS = 6.4e-4
RW_COLS = 3 * RW_W + 2 * RW_DECAY_LORA + 2 * RW_A_LORA + RW_GATE_LORA

IN_COLS = ML_COLS + RW_COLS + 2 * D_MODEL

N_EXPERTS = 16
N_GROUPS = 4
EXPERTS_PER_GROUP = N_EXPERTS // N_GROUPS
GROUP_SCORE_TOPK = 2
TOP_K = 2
D_EXPERT = 512

kernel_name = "bidir_mlstm_rwkv7_gated_moe_dit"


def _split(u, sizes):
    idx = [int(i) for i in np.cumsum(sizes)[:-1]]
    return jnp.split(u, idx, axis=-1)


def _rmsnorm(u, g):
    uf = u.astype(jnp.float32)
    y = uf * lax.rsqrt(jnp.mean(uf * uf, axis=-1, keepdims=True) + NORM_EPS)
    return (y * g.astype(jnp.float32)).astype(u.dtype)


def _prev(u):
    return jnp.pad(u[:, :-1], ((0, 0), (1, 0), (0, 0)))


def _next(u):
    return jnp.pad(u[:, 1:], ((0, 0), (0, 1), (0, 0)))


def _grid_conv(u, taps, bias):
    bsz, t, ch = u.shape
    rows = t // GRID_W
    img = u.reshape(bsz, rows, GRID_W, ch)
    out = lax.conv_general_dilated(img, taps[:, :, None, :].astype(u.dtype), (1, 1), "SAME",
                                   dimension_numbers=("NHWC", "HWIO", "NHWC"), feature_group_count=ch)
    return out.reshape(bsz, t, ch) + bias


def _line_conv(u, taps, bias):
    row = taps[1]
    return row[0] * _prev(u) + row[1] * u + row[2] * _next(u) + bias


def _mlstm_zero_state(bsz):
    f32 = jnp.float32
    return (jnp.zeros((bsz, ML_HEADS, ML_DQK, ML_DV), f32), jnp.zeros((bsz, ML_HEADS, ML_DQK), f32),
            jnp.zeros((bsz, ML_HEADS), f32))


def _mlstm_state_update(state, k, v, ig, b):
    C, n, m = state
    g_end = b[..., -1:] - b + ig
    m_new = jnp.maximum(b[..., -1] + m, jnp.max(g_end, axis=-1))
    wk = jnp.exp(g_end - m_new[..., None])
    carry = jnp.exp(b[..., -1] + m - m_new)
    C_new = carry[..., None, None] * C + jnp.einsum("bhsd,bhse->bhde", k * wk[..., None], v)
    n_new = carry[..., None] * n + jnp.einsum("bhs,bhsd->bhd", wk, k)
    return (C_new, n_new, m_new)


def _mlstm_segment(state, q, k, v, ig, lf):
    C, n, m = state
    L = q.shape[2]
    b = jnp.cumsum(lf, axis=-1)
    logw = b[..., :, None] - b[..., None, :] + ig[..., None, :]
    logw = jnp.where(jnp.tril(jnp.ones((L, L), dtype=bool)), logw, -jnp.inf)
    inter = b + m[..., None]
    m_t = jnp.maximum(inter, jnp.max(logw, axis=-1))
    s = jnp.einsum("bhtd,bhsd->bhts", q, k) * jnp.exp(logw - m_t[..., None])
    w_inter = jnp.exp(inter - m_t)
    num = w_inter[..., None] * jnp.einsum("bhtd,bhde->bhte", q, C) + jnp.einsum("bhts,bhse->bhte", s, v)
    den = w_inter * jnp.einsum("bhtd,bhd->bht", q, n) + jnp.sum(s, axis=-1)
    h = num / jnp.maximum(jnp.abs(den), jnp.exp(-m_t))[..., None]
    return _mlstm_state_update(state, k, v, ig, b), h


def _mlstm_run(q, k, v, ig, lf, state, reverse):
    if reverse:
        q, k, v, ig, lf = (jnp.flip(a, axis=2) for a in (q, k, v, ig, lf))
    bsz, nh, t, _ = q.shape
    nc = t // ML_CHUNK

    def chunks(a):
        return jnp.moveaxis(a.reshape(bsz, nh, nc, ML_CHUNK, *a.shape[3:]), 2, 0)

    state, hs = lax.scan(lambda st, xs: _mlstm_segment(st, *xs), state,
                         tuple(chunks(a) for a in (q, k, v, ig, lf)))
    h = jnp.moveaxis(hs, 0, 2).reshape(bsz, nh, t, ML_DV)
    if reverse:
        h = jnp.flip(h, axis=2)
    return state, h


def _mlstm_final_state(k, v, ig, lf, state, reverse):
    if reverse:
        k, v, ig, lf = (jnp.flip(a, axis=2) for a in (k, v, ig, lf))
    return _mlstm_state_update(state, k, v, ig, jnp.cumsum(lf, axis=-1))


def _mlstm_inputs(p, conv, gate_b):
    f32 = jnp.float32
    qk, v, o, gates = _split(p, [2 * ML_QK, ML_V, ML_V, 4 * ML_HEADS])
    q, k = _split(conv(qk), [ML_QK, ML_QK])
    bsz, t, _ = p.shape

    def heads(a, d):
        return jnp.transpose(a.reshape(bsz, t, ML_HEADS, d), (0, 2, 1, 3)).astype(f32)

    q = heads(q, ML_DQK)
    k = heads(k, ML_DQK) * (ML_DQK ** -0.5)
    v = heads(v, ML_DV)
    pre = gates.reshape(bsz, t, 2, 2, ML_HEADS).astype(f32) + gate_b.astype(f32)
    pre = GATE_CAP * jnp.tanh(pre / GATE_CAP)
    pre = jnp.transpose(pre, (2, 3, 0, 4, 1))
    return q, k, v, o, pre[0], jax.nn.log_sigmoid(pre[1])


def _mlstm_readout(h, o, norm_g):
    h = h * lax.rsqrt(jnp.mean(h * h, axis=-1, keepdims=True) + NORM_EPS)
    bsz, nh, t, dv = h.shape
    h = jnp.transpose(h, (0, 2, 1, 3)).reshape(bsz, t, nh * dv)
    return (h * norm_g * jax.nn.sigmoid(o.astype(jnp.float32))).astype(o.dtype)


def _rwkv_inputs(p, mu, w_up, w0, a_up, a0, k_k, k_a):
    f32 = jnp.float32
    p = p + mu * (0.5 * (_prev(p) + _next(p)) - p)
    r, k, v, wd, ad, gd = _split(p, [RW_W, RW_W, RW_W, 2 * RW_DECAY_LORA, 2 * RW_A_LORA, RW_GATE_LORA])
    bsz, t, _ = p.shape
    wd = wd.reshape(bsz, t, 2, RW_DECAY_LORA)
    ad = ad.reshape(bsz, t, 2, RW_A_LORA)
    lw = (w0 + jnp.einsum("btdr,drc->btdc", jnp.tanh(wd), w_up)).astype(f32)
    decay = jnp.exp(-jnp.exp(-jax.nn.softplus(-lw) - 0.5))
    a = jax.nn.sigmoid((a0 + jnp.einsum("btdr,drc->btdc", ad, a_up)).astype(f32))

    def heads(u):
        return u.reshape(*u.shape[:-1], RW_HEADS, RW_N)

    kf = k.astype(f32)
    kk = heads(kf * k_k)
    kk = kk * lax.rsqrt(jnp.sum(kk * kk, axis=-1, keepdims=True) + 1e-12)
    kd = kf[:, :, None, :] * (1.0 + (a - 1.0) * k_a)
    return heads(r.astype(f32)), heads(kd), heads(v.astype(f32)), heads(decay), kk, heads(a), gd


def _rwkv7_update(S, k, v, w, kk, a):
    sa = jnp.einsum("bhij,bhj->bhi", S, kk)
    return S * w[:, :, None, :] - sa[..., None] * (kk * a)[:, :, None, :] + v[..., None] * k[:, :, None, :]


def _rwkv7_run(r, k, v, w, kk, a, state, reverse):
    xs = tuple(jnp.moveaxis(u, 1, 0) for u in (r, k, v, w, kk, a))

    def step(S, inp):
        r_t, k_t, v_t, w_t, kk_t, a_t = inp
        S = _rwkv7_update(S, k_t, v_t, w_t, kk_t, a_t)
        return S, jnp.einsum("bhij,bhj->bhi", S, r_t)

    state, ys = lax.scan(step, state, xs, reverse=reverse)
    return state, jnp.moveaxis(ys, 0, 1)


def _rwkv7_final_state(k, v, w, kk, a, state, reverse):
    xs = tuple(jnp.moveaxis(u, 1, 0) for u in (k, v, w, kk, a))
    state, _ = lax.scan(lambda S, inp: (_rwkv7_update(S, *inp), None), state, xs, reverse=reverse)
    return state


def _rwkv_readout(y, r, kd, v, gd, r_k, ln_w, ln_b, g_up):
    bsz, t = y.shape[:2]
    mu = jnp.mean(y, axis=-1, keepdims=True)
    var = jnp.mean(jnp.square(y - mu), axis=-1, keepdims=True)
    yn = ((y - mu) * lax.rsqrt(var + RW_GN_EPS)).reshape(bsz, t, RW_W) * ln_w + ln_b
    bonus = jnp.sum(r[:, :, None] * kd * r_k, axis=(2, 4))[..., None] * v
    g = jax.nn.sigmoid(gd) @ g_up
    return ((yn + bonus.reshape(bsz, t, RW_W)) * g).astype(g.dtype)


def _merge(ha, hb, gates, p_a, p_b, w_out):
    ga, gb = _split(gates, [D_MODEL, D_MODEL])
    return (jax.nn.sigmoid(ga) * (ha @ p_a) + jax.nn.sigmoid(gb) * (hb @ p_b)) @ w_out


def _hybrid_mixer(h_lat, h_ctx, w_in, conv_k, conv_b, gate_b, ml_norm_g, rw_mu, rw_w_up, rw_w0, rw_a_up,
                  rw_a0, rw_g_up, rw_k_k, rw_k_a, rw_r_k, rw_ln_w, rw_ln_b, p_a, p_b, w_out, need_ctx):
    bsz = h_lat.shape[0]
    ml_l, rw_l, gt_l = _split(h_lat @ w_in, [ML_COLS, RW_COLS, 2 * D_MODEL])
    ml_c, rw_c, gt_c = _split(h_ctx @ w_in, [ML_COLS, RW_COLS, 2 * D_MODEL])

    ql, kl, vl, ol, igl, lfl = _mlstm_inputs(ml_l, lambda u: _grid_conv(u, conv_k, conv_b), gate_b)
    qc, kc, vc, oc, igc, lfc = _mlstm_inputs(ml_c, lambda u: _line_conv(u, conv_k, conv_b), gate_b)
    zero = _mlstm_zero_state(bsz)
    if need_ctx:
        mst_f, mhc_f = _mlstm_run(qc, kc, vc, igc[0], lfc[0], zero, False)
        mst_b, mhc_b = _mlstm_run(qc, kc, vc, igc[1], lfc[1], zero, True)
    else:
        mst_f = _mlstm_final_state(kc, vc, igc[0], lfc[0], zero, False)
        mst_b = _mlstm_final_state(kc, vc, igc[1], lfc[1], zero, True)
    _, mhl_f = _mlstm_run(ql, kl, vl, igl[0], lfl[0], mst_f, False)
    _, mhl_b = _mlstm_run(ql, kl, vl, igl[1], lfl[1], mst_b, True)
    a_lat = _mlstm_readout(mhl_f + mhl_b, ol, ml_norm_g)

    rw_par = (rw_mu, rw_w_up, rw_w0, rw_a_up, rw_a0, rw_k_k, rw_k_a)
    rl, kdl, vvl, wl, kkl, al, gdl = _rwkv_inputs(rw_l, *rw_par)
    rc, kdc, vvc, wc, kkc, ac, gdc = _rwkv_inputs(rw_c, *rw_par)
    s0 = jnp.zeros((bsz, RW_HEADS, RW_N, RW_N), jnp.float32)
    if need_ctx:
        rst_f, ryc_f = _rwkv7_run(rc, kdc[:, :, 0], vvc, wc[:, :, 0], kkc, ac[:, :, 0], s0, False)
        rst_b, ryc_b = _rwkv7_run(rc, kdc[:, :, 1], vvc, wc[:, :, 1], kkc, ac[:, :, 1], s0, True)
    else:
        rst_f = _rwkv7_final_state(kdc[:, :, 0], vvc, wc[:, :, 0], kkc, ac[:, :, 0], s0, False)
        rst_b = _rwkv7_final_state(kdc[:, :, 1], vvc, wc[:, :, 1], kkc, ac[:, :, 1], s0, True)
    _, ryl_f = _rwkv7_run(rl, kdl[:, :, 0], vvl, wl[:, :, 0], kkl, al[:, :, 0], rst_f, False)
    _, ryl_b = _rwkv7_run(rl, kdl[:, :, 1], vvl, wl[:, :, 1], kkl, al[:, :, 1], rst_b, True)
    b_lat = _rwkv_readout(ryl_f + ryl_b, rl, kdl, vvl, gdl, rw_r_k, rw_ln_w, rw_ln_b, rw_g_up)

    out_lat = _merge(a_lat, b_lat, gt_l, p_a, p_b, w_out)
    out_ctx = None
    if need_ctx:
        a_ctx = _mlstm_readout(mhc_f + mhc_b, oc, ml_norm_g)
        b_ctx = _rwkv_readout(ryc_f + ryc_b, rc, kdc, vvc, gdc, rw_r_k, rw_ln_w, rw_ln_b, rw_g_up)
        out_ctx = _merge(a_ctx, b_ctx, gt_c, p_a, p_b, w_out)
    return out_lat, out_ctx


def _moe(h, router_w, router_b, w_gate, w_up, w_down):
    bsz, t, d = h.shape
    hf = h.reshape(bsz * t, d)
    scores = jax.nn.sigmoid((hf @ router_w).astype(jnp.float32))
    sel = scores + router_b.astype(jnp.float32)
    grp = sel.reshape(-1, N_GROUPS, EXPERTS_PER_GROUP)
    group_score = jnp.sum(lax.top_k(grp, GROUP_SCORE_TOPK)[0], axis=-1)
    best = jnp.argmax(group_score, axis=-1)
    in_group = (jnp.arange(N_EXPERTS) // EXPERTS_PER_GROUP)[None, :] == best[:, None]
    _, idx = lax.top_k(jnp.where(in_group, sel, -jnp.inf), TOP_K)
    wsel = jnp.take_along_axis(scores, idx, axis=-1)
    wsel = wsel / jnp.sum(wsel, axis=-1, keepdims=True)
    comb = jnp.sum(jax.nn.one_hot(idx, N_EXPERTS, dtype=jnp.float32) * wsel[..., None], axis=1).astype(h.dtype)
    y = jnp.zeros_like(hf)
    for e in range(N_EXPERTS):
        hid = jax.nn.silu(hf @ w_gate[e]) * (hf @ w_up[e])
        y = y + (comb[:, e:e + 1] * hid) @ w_down[e]
    return y.reshape(bsz, t, d)


def setup_inputs(seed: int = 0) -> dict:
    key = jax.random.key(seed)
    ks = list(jax.random.split(key, 40))
    f32 = jnp.float32
    L = DEPTH

    def nrm(i, shape, scale):
        return scale * jax.random.normal(ks[i], shape, f32)

    def gain(i, shape):
        return 1.0 + nrm(i, shape, 0.02)

    i_bias = nrm(12, (L, 1, 2, ML_HEADS), 0.1)
    f_bias = jax.random.uniform(ks[13], (L, 1, 2, ML_HEADS), f32, 3.0, 6.0)
    centre = jnp.zeros((3, 3, 1), f32).at[1, 1, 0].set(1.0)
    return {
        "x": nrm(0, (BATCH, SEQ, D_MODEL), 1.0),
        "c": nrm(1, (BATCH, D_MODEL), 1.0),
        "ctx": nrm(2, (BATCH, CTX_LEN, D_MODEL), 1.0),
        "c_ctx": nrm(3, (D_MODEL,), 1.0),
        "w_ada": nrm(4, (L, D_MODEL, N_MOD * D_MODEL), 0.5 * D_MODEL ** -0.5),
        "b_ada": nrm(5, (L, N_MOD * D_MODEL), 0.02),
        "norm1_g": gain(6, (L, D_MODEL)),
        "norm2_g": gain(7, (L, D_MODEL)),
        "w_in": nrm(8, (L, D_MODEL, IN_COLS), D_MODEL ** -0.5),
        "ml_conv_k": centre + nrm(9, (L, 3, 3, 2 * ML_QK), 0.1),
        "ml_conv_b": nrm(10, (L, 2 * ML_QK), 0.02),
        "ml_gate_b": jnp.concatenate([i_bias, f_bias], axis=1),
        "ml_norm_g": gain(11, (L, ML_V)),
        "rw_mu": jax.random.uniform(ks[14], (L, RW_COLS), f32, 0.0, 1.0),
        "rw_w_up": nrm(15, (L, 2, RW_DECAY_LORA, RW_W), 0.5 * RW_DECAY_LORA ** -0.5),
        "rw_w0": jax.random.uniform(ks[16], (L, 2, RW_W), f32, -6.0, -1.0),
        "rw_a_up": nrm(17, (L, 2, RW_A_LORA, RW_W), 0.5 * RW_A_LORA ** -0.5),
        "rw_a0": nrm(18, (L, 2, RW_W), 0.1),
        "rw_g_up": nrm(19, (L, RW_GATE_LORA, RW_W), RW_GATE_LORA ** -0.5),
        "rw_k_k": 0.85 + nrm(20, (L, RW_W), 0.02),
        "rw_k_a": gain(21, (L, RW_W)),
        "rw_r_k": nrm(22, (L, RW_HEADS, RW_N), 0.1),
        "rw_ln_w": gain(23, (L, RW_W)),
        "rw_ln_b": nrm(24, (L, RW_W), 0.02),
        "merge_pa": nrm(25, (L, ML_V, D_MODEL), ML_V ** -0.5),
        "merge_pb": nrm(26, (L, RW_W, D_MODEL), RW_W ** -0.5),
        "w_out": nrm(27, (L, D_MODEL, D_MODEL), D_MODEL ** -0.5),
        "router_w": nrm(28, (D_MODEL, N_EXPERTS), D_MODEL ** -0.5),
        "router_b": nrm(29, (N_EXPERTS,), 0.01),
        "exp_w_gate": nrm(30, (L, N_EXPERTS, D_MODEL, D_EXPERT), D_MODEL ** -0.5),
        "exp_w_up": nrm(31, (L, N_EXPERTS, D_MODEL, D_EXPERT), D_MODEL ** -0.5),
        "exp_w_down": nrm(32, (L, N_EXPERTS, D_EXPERT, D_MODEL), D_EXPERT ** -0.5),
        "final_g": gain(33, (D_MODEL,)),
    }


def reference(x, c, ctx, c_ctx, w_ada, b_ada, norm1_g, norm2_g, w_in, ml_conv_k, ml_conv_b, ml_gate_b,
              ml_norm_g, rw_mu, rw_w_up, rw_w0, rw_a_up, rw_a0, rw_g_up, rw_k_k, rw_k_a, rw_r_k, rw_ln_w,
              rw_ln_b, merge_pa, merge_pb, w_out, router_w, router_b, exp_w_gate, exp_w_up, exp_w_down,
              final_g):
    f32 = jnp.float32
    s_lat = jax.nn.silu(c.astype(f32))
    s_ctx = jax.nn.silu(c_ctx.astype(f32))
    x_lat, x_ctx = x, ctx
    for l in range(DEPTH):
        last = l == DEPTH - 1
        sh1, sc1, g1, sh2, sc2, g2 = _split((s_lat @ w_ada[l] + b_ada[l]).astype(x.dtype)[:, None, :],
                                            [D_MODEL] * N_MOD)
        csh1, csc1, cg1, csh2, csc2, cg2 = _split((s_ctx @ w_ada[l] + b_ada[l]).astype(x.dtype),
                                                  [D_MODEL] * N_MOD)
        h_lat = _rmsnorm(x_lat, norm1_g[l]) * (1 + sc1) + sh1
        h_ctx = _rmsnorm(x_ctx, norm1_g[l]) * (1 + csc1) + csh1
        mix_lat, mix_ctx = _hybrid_mixer(
            h_lat, h_ctx, w_in[l], ml_conv_k[l], ml_conv_b[l], ml_gate_b[l], ml_norm_g[l], rw_mu[l],
            rw_w_up[l], rw_w0[l], rw_a_up[l], rw_a0[l], rw_g_up[l], rw_k_k[l], rw_k_a[l], rw_r_k[l],
            rw_ln_w[l], rw_ln_b[l], merge_pa[l], merge_pb[l], w_out[l], not last)
        moe_w = (router_w, router_b, exp_w_gate[l], exp_w_up[l], exp_w_down[l])
        x_lat = x_lat + g1 * mix_lat
        x_lat = x_lat + g2 * _moe(_rmsnorm(x_lat, norm2_g[l]) * (1 + sc2) + sh2, *moe_w)
        if not last:
            x_ctx = x_ctx + cg1 * mix_ctx
            x_ctx = x_ctx + cg2 * _moe(_rmsnorm(x_ctx, norm2_g[l]) * (1 + csc2) + csh2, *moe_w)
    return _rmsnorm(x_lat, final_g)
```

```cpp
#include <hip/hip_runtime.h>
#include <cstdio>
#include <cstdint>

#ifndef MK_PER_PHASE
#define MK_PER_PHASE 0
#endif

#ifndef ONLY_SUB
#define ONLY_SUB -1
#endif
#define SUB_ON(k) (ONLY_SUB < 0 || ONLY_SUB == (k))
#define LAS __attribute__((address_space(3)))
typedef unsigned short bf16_t;
typedef short bf16x8 __attribute__((ext_vector_type(8)));
typedef float f32x4 __attribute__((ext_vector_type(4)));
typedef unsigned u32x4 __attribute__((ext_vector_type(4)));
typedef unsigned u32x2 __attribute__((ext_vector_type(2)));

namespace {
constexpr int D = 1024, NBATCH = 2, TL = 8192, TC = 256;
constexpr int RLAT = NBATCH * TL, RCTX = NBATCH * TC, RT = RLAT + RCTX;
constexpr int ML_H = 4, ML_COLS = 1552;
constexpr int RW_H = 8, RW_W = 512, RW_COLS = 1920, GT_COLS = 2048, IN_COLS = 5520, IN_PAD = 5632;
constexpr int NE = 16, DE = 512;
constexpr int NCH = 132;
constexpr int SEQ = TC + TL;
constexpr float NORM_EPS = 1e-6f, GATE_CAP = 15.0f, RW_GN_EPS = 6.4e-4f;
constexpr int NPHASE = 28;

constexpr size_t WS_CTL = 0;
constexpr size_t CTL_BYTES = 65536;
constexpr size_t CW_BAR = 0;
constexpr size_t CW_CNT = 4096;
constexpr size_t WS_MOD = WS_CTL + CTL_BYTES;
constexpr size_t WS_XCTX = WS_MOD + 163840;
constexpr size_t WS_WIN = WS_XCTX + (size_t)RCTX * D * 4;
constexpr size_t WS_WPA = WS_WIN + (size_t)IN_PAD * D * 2;
constexpr size_t WS_WPB = WS_WPA + (size_t)D * 512 * 2;
constexpr size_t WS_WOUT = WS_WPB + (size_t)D * 512 * 2;
constexpr size_t WS_WUP = WS_WOUT + (size_t)D * D * 2;
constexpr size_t WS_AUP = WS_WUP + 2 * 512 * 64 * 2;
constexpr size_t WS_GUP = WS_AUP + 2 * 512 * 64 * 2;
constexpr size_t WS_ARENA = WS_GUP + 512 * 128 * 2;
constexpr size_t SZ_PGT = (size_t)RT * GT_COLS * 2, SZ_PRW = (size_t)RT * RW_COLS * 2, SZ_PML = (size_t)RT * ML_COLS * 2;
constexpr size_t SZ_R1K = (size_t)RT * D * 2;
constexpr size_t SZ_R512 = (size_t)RT * 512 * 2;
constexpr size_t A_PGT = WS_ARENA;
constexpr size_t A_PRW = A_PGT + SZ_PGT;
constexpr size_t A_PML = A_PRW + SZ_PRW;
constexpr size_t A_H = A_PML + SZ_PML;
constexpr size_t A_DC = A_H;
constexpr size_t A_DN = A_DC + (size_t)16 * NCH * 8192 * 4;
constexpr size_t A_G = A_DN + (size_t)16 * NCH * 64 * 4;
constexpr size_t A_ALAT = A_G + (size_t)16 * NCH * 4;
constexpr size_t A_SR = A_ALAT + SZ_R512;
constexpr size_t A_SV = A_SR + SZ_R512;
constexpr size_t A_SG = A_SV + SZ_R512;
constexpr size_t A_BONUS = A_SG + SZ_R512;
constexpr size_t A_BLAT = A_BONUS + (size_t)RT * 8 * 4;
constexpr size_t A_END = A_BLAT + SZ_R512;
constexpr size_t A_SOMW0 = A_PML;
constexpr size_t A_SOMW1 = A_SOMW0 + SZ_R512, A_SKKA0 = A_SOMW1 + SZ_R512, A_SKKA1 = A_SKKA0 + SZ_R512;
constexpr size_t A_SKD0 = A_SKKA1 + SZ_R512, A_SKD1 = A_SKD0 + SZ_R512, A_SKK = A_SKD1 + SZ_R512;
static_assert(A_SKK + SZ_R512 <= A_DN, "stream overlay");
constexpr size_t A_Y = A_PRW;
static_assert((size_t)2 * 16 * 64 * SEQ * 2 <= SZ_PRW, "Y overlay");
constexpr size_t A_U = A_PML;
constexpr size_t A_H2 = A_U + SZ_R1K;
constexpr size_t A_WG = A_H2 + SZ_R1K;
constexpr size_t A_WU = A_WG + (size_t)NE * DE * D * 2;
constexpr size_t A_WD = A_WU + (size_t)NE * DE * D * 2;
static_assert(A_WD + (size_t)NE * DE * D * 2 <= A_ALAT, "expert weight overlay");
constexpr size_t A_LIST = A_ALAT;
constexpr size_t A_TOKW = A_LIST + (size_t)NE * RT * 4;
static_assert(A_TOKW + (size_t)RT * 8 <= A_SR, "list overlay");
constexpr size_t A_HID = A_PGT;
constexpr size_t A_CONTRIB = A_HID + (size_t)2 * RT * DE * 2;
static_assert(A_CONTRIB + (size_t)2 * RT * D * 2 <= A_PML, "contrib overlay");
constexpr size_t WS_NEED = A_END;

constexpr int LDS_BYTES = 147456;
constexpr int LDS_MISC = 147456 - 256;

__device__ __forceinline__ float bf2f(unsigned h) { return __uint_as_float(h << 16); }
__device__ __forceinline__ unsigned f2bf(float f) { unsigned u = __float_as_uint(f); return (u + 0x7fffu + ((u >> 16) & 1u)) >> 16; }
__device__ __forceinline__ unsigned pk2(float lo, float hi) { return f2bf(lo) | (f2bf(hi) << 16); }
__device__ __forceinline__ float sigmoidf_(float x) { return 1.0f / (1.0f + __expf(-x)); }
__device__ __forceinline__ float siluf_(float x) { return x / (1.0f + __expf(-x)); }
__device__ __forceinline__ float tanhf_(float x) { return 1.0f - 2.0f / (__expf(2.0f * x) + 1.0f); }
__device__ __forceinline__ float softplusf_(float x) { return fmaxf(x, 0.f) + __logf(1.0f + __expf(-fabsf(x))); }
__device__ __forceinline__ float wave_sum_shfl(float v) {
#pragma unroll
    for (int o = 1; o < 64; o <<= 1) v += __shfl_xor(v, o);
    return v;
}
template <int CTRL> __device__ __forceinline__ float dpp_mov(float v) {
    return __int_as_float(__builtin_amdgcn_update_dpp(0, __float_as_int(v), CTRL, 0xf, 0xf, true));
}
__device__ __forceinline__ float wave_sum_dpp(float v) {
    v += dpp_mov<0xB1>(v);
    v += dpp_mov<0x4E>(v);
    v += dpp_mov<0x141>(v);
    v += dpp_mov<0x140>(v);
    { auto r = __builtin_amdgcn_permlane16_swap(__float_as_uint(v), __float_as_uint(v), false, false); unsigned a = r[0], b = r[1]; v = __uint_as_float(a) + __uint_as_float(b); }
    { auto r = __builtin_amdgcn_permlane32_swap(__float_as_uint(v), __float_as_uint(v), false, false); unsigned a = r[0], b = r[1]; v = __uint_as_float(a) + __uint_as_float(b); }
    return v;
}
__device__ __forceinline__ void unpack8(u32x4 w, float (&o)[8]) {
    o[0] = bf2f(w.x & 0xffffu); o[1] = __uint_as_float(w.x & 0xffff0000u); o[2] = bf2f(w.y & 0xffffu); o[3] = __uint_as_float(w.y & 0xffff0000u);
    o[4] = bf2f(w.z & 0xffffu); o[5] = __uint_as_float(w.z & 0xffff0000u); o[6] = bf2f(w.w & 0xffffu); o[7] = __uint_as_float(w.w & 0xffff0000u);
}
__device__ __forceinline__ void unpack4(u32x2 w, float (&o)[4]) {
    o[0] = bf2f(w.x & 0xffffu); o[1] = __uint_as_float(w.x & 0xffff0000u); o[2] = bf2f(w.y & 0xffffu); o[3] = __uint_as_float(w.y & 0xffff0000u);
}

#define XB_TMO      128
#define XB_XCNT(j)  (256  + 64 * (j))
#define XB_XSUB(j)  (1280 + 64 * (j))
#define XB_XGEN(j)  (2304 + 64 * (j))
#define XB_TOP      3328
#define XB_TOPGEN   3392
#define XCD_BAR_WORDS 3456
#define XB_SPIN_CAP (1u << 24)
__device__ __forceinline__ unsigned xb_ld(unsigned* p)              { return __hip_atomic_load(p, __ATOMIC_RELAXED, __HIP_MEMORY_SCOPE_AGENT); }
__device__ __forceinline__ unsigned xb_add(unsigned* p, unsigned v) { return __hip_atomic_fetch_add(p, v, __ATOMIC_RELAXED, __HIP_MEMORY_SCOPE_AGENT); }
__device__ __forceinline__ unsigned xb_xcc_id() { return (unsigned)__builtin_amdgcn_s_getreg((3 << 11) | 20) & 0xFu; }
#define XB_SPIN(cond, bar) do { unsigned _sp = 0; while (cond) { __builtin_amdgcn_s_sleep(1); \
    if ((++_sp & 255u) == 0u) { if (xb_ld(&(bar)[XB_TMO])) break; if (_sp > XB_SPIN_CAP) { atomicAdd(&(bar)[XB_TMO], 1u); break; } } } } while (0)
struct XcdBarrier { unsigned* bar; unsigned x; volatile LAS unsigned* st; };
__device__ __forceinline__ XcdBarrier xcd_barrier_post(unsigned* bar, volatile LAS unsigned* st) {
    XcdBarrier b; b.bar = bar; b.x = xb_xcc_id(); b.st = st;
    if (threadIdx.x == 0) (void)xb_add(&bar[XB_XCNT(b.x)], 1u);
    return b;
}
__device__ __forceinline__ void xcd_barrier_complete(unsigned* bar, unsigned x, unsigned& nloc, unsigned& nx) {
    const unsigned G = gridDim.x * gridDim.y * gridDim.z;
    unsigned sum, cnt, mine, sp = 0u;
    for (;;) {
        sum = 0u; cnt = 0u; mine = 0u;
#pragma unroll
        for (unsigned j = 0; j < 16; ++j) { const unsigned c = xb_ld(&bar[XB_XCNT(j)]); sum += c; cnt += (c > 0u) ? 1u : 0u; mine = (j == x) ? c : mine; }
        if (sum == G) break;
        __builtin_amdgcn_s_sleep(1);
        if ((++sp & 255u) == 0u) { if (xb_ld(&bar[XB_TMO])) break; if (sp > XB_SPIN_CAP) { atomicAdd(&bar[XB_TMO], 1u); break; } }
    }
    nloc = mine > 0u ? mine : 1u; nx = cnt > 0u ? cnt : 1u;
}
__device__ __forceinline__ void xcd_barrier(const XcdBarrier& b) {
    asm volatile("s_waitcnt vmcnt(0)" ::: "memory");
    __syncthreads();
    if (threadIdx.x == 0) {
        unsigned* bar = b.bar;
        __builtin_amdgcn_s_waitcnt(0);
        unsigned nloc = b.st[0], nx = b.st[1];
        if (nloc == 0u) { xcd_barrier_complete(bar, b.x, nloc, nx); b.st[0] = nloc; b.st[1] = nx; }
        const unsigned old = xb_add(&bar[XB_XSUB(b.x)], 1u);
        const unsigned gen = old / nloc;
        if (old + 1u == (gen + 1u) * nloc) {
            __builtin_amdgcn_fence(__ATOMIC_RELEASE, "agent");
            asm volatile("s_waitcnt vmcnt(0)" ::: "memory");
            const unsigned og = xb_add(&bar[XB_TOP], 1u);
            const unsigned tg = og / nx;
            if (og + 1u == (tg + 1u) * nx) xb_add(&bar[XB_TOPGEN], 1u);
            else XB_SPIN(xb_ld(&bar[XB_TOPGEN]) == tg, bar);
            __builtin_amdgcn_fence(__ATOMIC_ACQUIRE, "agent");
            xb_add(&bar[XB_XGEN(b.x)], 1u);
            asm volatile("s_waitcnt vmcnt(0)" ::: "memory");
        } else {
            XB_SPIN(xb_ld(&bar[XB_XGEN(b.x)]) == gen, bar);
            __builtin_amdgcn_fence(__ATOMIC_ACQUIRE, "agent");
            asm volatile("s_waitcnt vmcnt(0)" ::: "memory");
        }
    }
    __syncthreads();
}

struct Args { const float* in[33]; float* out; unsigned char* ws; int ph_lo, ph_hi; };
enum { I_X = 0, I_C, I_CTX, I_CCTX, I_WADA, I_BADA, I_N1G, I_N2G, I_WIN, I_CONVK, I_CONVB, I_GATEB, I_MLNG, I_MU, I_WUP, I_W0, I_AUP, I_A0, I_GUP, I_KK, I_KA, I_RK,
       I_LNW, I_LNB, I_PA, I_PB, I_WOUT, I_RTW, I_RTB, I_EG, I_EU, I_ED, I_FG };

__device__ __forceinline__ int row_mv(int r) { return r < RLAT ? (r >> 13) : 2; }

__device__ __forceinline__ void conv_item(const float* __restrict__ W, int K, int N, bf16_t* __restrict__ WT, int item, int lane) {
    const int nkb = K >> 6;
    const int nb = item / nkb, kb = item - nb * nkb;
    const int n = nb * 64 + lane, k0 = kb * 64;
    float v[64];
    if (n < N) {
        const float* p = W + (size_t)k0 * N + n;
#pragma unroll
        for (int i = 0; i < 64; ++i) v[i] = p[(size_t)i * N];
    } else {
#pragma unroll
        for (int i = 0; i < 64; ++i) v[i] = 0.f;
    }
    u32x4* o = (u32x4*)(WT + (size_t)n * K + k0);
#pragma unroll
    for (int i = 0; i < 8; ++i) { u32x4 w; w.x = pk2(v[8 * i], v[8 * i + 1]); w.y = pk2(v[8 * i + 2], v[8 * i + 3]); w.z = pk2(v[8 * i + 4], v[8 * i + 5]); w.w = pk2(v[8 * i + 6], v[8 * i + 7]); o[i] = w; }
}
constexpr int CONV_CORE_ITEMS = 1408 + 128 + 128 + 256 + 16 + 16 + 16;
__device__ __forceinline__ void conv_core(const Args& a, int l, int item, int lane) {
    unsigned char* ws = a.ws;
    if (item < 1408) { conv_item(a.in[I_WIN] + (size_t)l * D * IN_COLS, D, IN_COLS, (bf16_t*)(ws + WS_WIN), item, lane); return; } item -= 1408;
    if (item < 128) { conv_item(a.in[I_PA] + (size_t)l * 512 * D, 512, D, (bf16_t*)(ws + WS_WPA), item, lane); return; } item -= 128;
    if (item < 128) { conv_item(a.in[I_PB] + (size_t)l * 512 * D, 512, D, (bf16_t*)(ws + WS_WPB), item, lane); return; } item -= 128;
    if (item < 256) { conv_item(a.in[I_WOUT] + (size_t)l * D * D, D, D, (bf16_t*)(ws + WS_WOUT), item, lane); return; } item -= 256;
    if (item < 16) { const int d = item >> 3; conv_item(a.in[I_WUP] + (size_t)(l * 2 + d) * 64 * 512, 64, 512, (bf16_t*)(ws + WS_WUP) + d * 512 * 64, item & 7, lane); return; } item -= 16;
    if (item < 16) { const int d = item >> 3; conv_item(a.in[I_AUP] + (size_t)(l * 2 + d) * 64 * 512, 64, 512, (bf16_t*)(ws + WS_AUP) + d * 512 * 64, item & 7, lane); return; } item -= 16;
    conv_item(a.in[I_GUP] + (size_t)l * 128 * 512, 128, 512, (bf16_t*)(ws + WS_GUP), item, lane);
}
constexpr int CONV_EXP_ITEMS = 3 * 2048;
__device__ __forceinline__ void conv_exp(const Args& a, int l, int item, int lane) {
    unsigned char* ws = a.ws;
    const int which = item >> 11, it = item & 2047, e = it >> 7, sub = it & 127;
    if (which == 0) conv_item(a.in[I_EG] + ((size_t)l * NE + e) * D * DE, D, DE, (bf16_t*)(ws + A_WG) + (size_t)e * DE * D, sub, lane);
    else if (which == 1) conv_item(a.in[I_EU] + ((size_t)l * NE + e) * D * DE, D, DE, (bf16_t*)(ws + A_WU) + (size_t)e * DE * D, sub, lane);
    else conv_item(a.in[I_ED] + ((size_t)l * NE + e) * DE * D, DE, D, (bf16_t*)(ws + A_WD) + (size_t)e * D * DE, sub, lane);
}

__device__ __forceinline__ void phase_mod(const Args& a, LAS unsigned char* lds, int tid, int lane, int wave) {
    LAS float* sv = (LAS float*)lds;
    LAS float* part = sv + 3 * 1024;
    for (int i = tid; i < 3 * 1024; i += 512) {
        const int v = i >> 10, k = i & 1023;
        const float c = (v < 2) ? a.in[I_C][v * 1024 + k] : a.in[I_CCTX][k];
        sv[i] = siluf_(c);
    }
    __syncthreads();
    float* MOD = (float*)(a.ws + WS_MOD);
    for (int cb = blockIdx.x; cb < 256; cb += gridDim.x) {
        const int gc0 = cb * 48, l = gc0 / 6144, n0 = gc0 % 6144;
        float acc0 = 0.f, acc1 = 0.f, acc2 = 0.f;
        if (lane < 48) {
            const float* w = a.in[I_WADA] + (size_t)l * D * 6144 + n0 + lane;
            const int k0 = wave * 128;
#pragma unroll 8
            for (int k = 0; k < 128; ++k) { const float wv = w[(size_t)(k0 + k) * 6144]; acc0 += sv[k0 + k] * wv; acc1 += sv[1024 + k0 + k] * wv; acc2 += sv[2048 + k0 + k] * wv; }
            part[(wave * 3 + 0) * 48 + lane] = acc0; part[(wave * 3 + 1) * 48 + lane] = acc1; part[(wave * 3 + 2) * 48 + lane] = acc2;
        }
        __syncthreads();
        if (tid < 144) {
            const int v = tid / 48, j = tid % 48;
            float s = a.in[I_BADA][l * 6144 + n0 + j];
#pragma unroll
            for (int w8 = 0; w8 < 8; ++w8) s += part[(w8 * 3 + v) * 48 + j];
            MOD[((size_t)l * 3 + v) * 6144 + n0 + j] = s;
        }
        __syncthreads();
    }
}

__device__ __forceinline__ const float* xrow_in(const Args& a, int l, int r) {
    if (r < RLAT) return (l == 0 ? a.in[I_X] : (const float*)a.out) + (size_t)r * D;
    return (l == 0 ? a.in[I_CTX] : (const float*)(a.ws + WS_XCTX)) + (size_t)(r - RLAT) * D;
}
__device__ __forceinline__ float* xrow_out(const Args& a, int r) {
    if (r < RLAT) return a.out + (size_t)r * D;
    return (float*)(a.ws + WS_XCTX) + (size_t)(r - RLAT) * D;
}
__device__ __forceinline__ void norm_mod_row(const f32x4 (&v)[4], const float* __restrict__ g, const float* __restrict__ sh, const float* __restrict__ sc, bf16_t* __restrict__ orow, int lane, f32x4 (&hout)[4]) {
    float s = 0.f;
#pragma unroll
    for (int j = 0; j < 4; ++j) s += (v[j].x * v[j].x + v[j].y * v[j].y) + (v[j].z * v[j].z + v[j].w * v[j].w);
    s = wave_sum_shfl(s);
    const float rstd = rsqrtf(s * (1.0f / D) + NORM_EPS);
#pragma unroll
    for (int j = 0; j < 4; ++j) {
        const int idx = 4 * lane + 256 * j;
        const f32x4 gg = *(const f32x4*)(g + idx), s1 = *(const f32x4*)(sc + idx), s0 = *(const f32x4*)(sh + idx);
        f32x4 h;
        h.x = v[j].x * rstd * gg.x * (1.f + s1.x) + s0.x; h.y = v[j].y * rstd * gg.y * (1.f + s1.y) + s0.y;
        h.z = v[j].z * rstd * gg.z * (1.f + s1.z) + s0.z; h.w = v[j].w * rstd * gg.w * (1.f + s1.w) + s0.w;
        hout[j] = h;
        u32x2 o; o.x = pk2(h.x, h.y); o.y = pk2(h.z, h.w);
        *(u32x2*)(orow + idx) = o;
    }
}
__device__ __forceinline__ void phase_norm1(const Args& a, int l, int lane, int gw, int nw) {
    const float* MOD = (const float*)(a.ws + WS_MOD);
    bf16_t* H = (bf16_t*)(a.ws + A_H);
    for (int r = gw; r < RT; r += nw) {
        const float* xr = xrow_in(a, l, r);
        f32x4 v[4], h[4];
#pragma unroll
        for (int j = 0; j < 4; ++j) v[j] = *(const f32x4*)(xr + 4 * lane + 256 * j);
        const float* m = MOD + ((size_t)l * 3 + row_mv(r)) * 6144;
        norm_mod_row(v, a.in[I_N1G] + l * D, m, m + 1024, H + (size_t)r * D, lane, h);
    }
}

constexpr int G_LD = 72;
constexpr int G_OPER = 128 * G_LD;
__device__ __forceinline__ void gemm_tile(LAS bf16_t* sm, const bf16_t* pa0, const bf16_t* pa1, const bf16_t* pb0, const bf16_t* pb1, int nk,
                                          f32x4 (&acc)[4][2], int tid, int lane, int wm, int wn) {
    const int srow = tid >> 3, skc = tid & 7;
    const int so0 = srow * G_LD + skc * 8, so1 = (srow + 64) * G_LD + skc * 8;
    const int fr = lane & 15, fq = lane >> 4;
    u32x4 ra0 = *(const u32x4*)pa0, ra1 = *(const u32x4*)pa1, rb0 = *(const u32x4*)pb0, rb1 = *(const u32x4*)pb1;
    *(LAS u32x4*)(sm + so0) = ra0; *(LAS u32x4*)(sm + so1) = ra1; *(LAS u32x4*)(sm + G_OPER + so0) = rb0; *(LAS u32x4*)(sm + G_OPER + so1) = rb1;
    __syncthreads();
    for (int ks = 0; ks < nk; ++ks) {
        LAS bf16_t* A = sm + (ks & 1) * 2 * G_OPER;
        LAS bf16_t* B = A + G_OPER;
        const bool more = (ks + 1 < nk);
        if (more) { const int ko = (ks + 1) * 64; ra0 = *(const u32x4*)(pa0 + ko); ra1 = *(const u32x4*)(pa1 + ko); rb0 = *(const u32x4*)(pb0 + ko); rb1 = *(const u32x4*)(pb1 + ko); }
#pragma unroll
        for (int kk = 0; kk < 2; ++kk) {
            bf16x8 af[4], bfr[2];
#pragma unroll
            for (int mi = 0; mi < 4; ++mi) af[mi] = *(const LAS bf16x8*)(A + (wm * 64 + mi * 16 + fr) * G_LD + kk * 32 + fq * 8);
#pragma unroll
            for (int ni = 0; ni < 2; ++ni) bfr[ni] = *(const LAS bf16x8*)(B + (wn * 32 + ni * 16 + fr) * G_LD + kk * 32 + fq * 8);
#pragma unroll
            for (int mi = 0; mi < 4; ++mi)
#pragma unroll
                for (int ni = 0; ni < 2; ++ni) acc[mi][ni] = __builtin_amdgcn_mfma_f32_16x16x32_bf16(bfr[ni], af[mi], acc[mi][ni], 0, 0, 0);
        }
        if (more) {
            LAS bf16_t* A2 = sm + ((ks + 1) & 1) * 2 * G_OPER;
            *(LAS u32x4*)(A2 + so0) = ra0; *(LAS u32x4*)(A2 + so1) = ra1; *(LAS u32x4*)(A2 + G_OPER + so0) = rb0; *(LAS u32x4*)(A2 + G_OPER + so1) = rb1;
        }
        __syncthreads();
    }
}
#define ZERO_ACC(acc) do { _Pragma("unroll") for (int _i = 0; _i < 4; ++_i) _Pragma("unroll") for (int _j = 0; _j < 2; ++_j) acc[_i][_j] = (f32x4){0.f, 0.f, 0.f, 0.f}; } while (0)

__device__ __forceinline__ void phase_inproj(const Args& a, LAS unsigned char* lds, int tid, int lane, int wave) {
    LAS bf16_t* sm = (LAS bf16_t*)lds;
    const bf16_t* H = (const bf16_t*)(a.ws + A_H);
    const bf16_t* WT = (const bf16_t*)(a.ws + WS_WIN);
    bf16_t* PML = (bf16_t*)(a.ws + A_PML); bf16_t* PRW = (bf16_t*)(a.ws + A_PRW); bf16_t* PGT = (bf16_t*)(a.ws + A_PGT);
    const int wm = wave >> 2, wn = wave & 3, fr = lane & 15, fq = lane >> 4;
    const int srow = tid >> 3, skc = tid & 7;
    constexpr int NM = RT / 128, NN = IN_PAD / 128;
    for (int tile = blockIdx.x; tile < NM * NN; tile += gridDim.x) {
        const int tm = tile / NN, tn = tile - tm * NN;
        const bf16_t* pa0 = H + (size_t)(tm * 128 + srow) * D + skc * 8;
        const bf16_t* pa1 = pa0 + (size_t)64 * D;
        const bf16_t* pb0 = WT + (size_t)(tn * 128 + srow) * D + skc * 8;
        const bf16_t* pb1 = pb0 + (size_t)64 * D;
        f32x4 acc[4][2]; ZERO_ACC(acc);
        gemm_tile(sm, pa0, pa1, pb0, pb1, D / 64, acc, tid, lane, wm, wn);
#pragma unroll
        for (int mi = 0; mi < 4; ++mi) {
            const int row = tm * 128 + wm * 64 + mi * 16 + fr;
#pragma unroll
            for (int ni = 0; ni < 2; ++ni) {
                const int nc = tn * 128 + wn * 32 + ni * 16 + 4 * fq;
                u32x2 o; o.x = pk2(acc[mi][ni][0], acc[mi][ni][1]); o.y = pk2(acc[mi][ni][2], acc[mi][ni][3]);
                if (nc < ML_COLS) *(u32x2*)(PML + (size_t)row * ML_COLS + nc) = o;
                else if (nc < ML_COLS + RW_COLS) *(u32x2*)(PRW + (size_t)row * RW_COLS + (nc - ML_COLS)) = o;
                else if (nc < IN_COLS) *(u32x2*)(PGT + (size_t)row * GT_COLS + (nc - ML_COLS - RW_COLS)) = o;
            }
        }
    }
}

template <int KS> __device__ __forceinline__ f32x4 lds_mma(const LAS bf16_t* A, int lda, int m0, const LAS bf16_t* Bt, int ldb, int n0, f32x4 acc, int fr, int fq) {
#pragma unroll
    for (int ks = 0; ks < KS; ++ks) {
        const bf16x8 av = *(const LAS bf16x8*)(A + (m0 + fr) * lda + ks * 32 + fq * 8);
        const bf16x8 bv = *(const LAS bf16x8*)(Bt + (n0 + fr) * ldb + ks * 32 + fq * 8);
        acc = __builtin_amdgcn_mfma_f32_16x16x32_bf16(bv, av, acc, 0, 0, 0);
    }
    return acc;
}

__device__ __forceinline__ int chunk_row0(int b, int cc) { return cc < 4 ? RLAT + b * TC + cc * 64 : b * TL + (cc - 4) * 64; }
__device__ __forceinline__ void ml_gates(const Args& a, int l, int h, int row0, LAS float* gt, int lane) {
    const bf16_t* PML = (const bf16_t*)(a.ws + A_PML);
    const float* gb = a.in[I_GATEB] + l * 16;
    const bf16_t* p = PML + (size_t)(row0 + lane) * ML_COLS + 1536;
    float pre[4];
#pragma unroll
    for (int ty = 0; ty < 2; ++ty)
#pragma unroll
        for (int d = 0; d < 2; ++d) {
            const int ix = ty * 8 + d * 4 + h;
            const float x = bf2f(p[ix]) + gb[ix];
            pre[ty * 2 + d] = GATE_CAP * tanhf_(x * (1.0f / GATE_CAP));
        }
    float lff = -softplusf_(-pre[2]);
    float lfb = -softplusf_(-pre[3]);
    float cf = lff, cb = lfb;
#pragma unroll
    for (int o = 1; o < 64; o <<= 1) {
        const float uf = __shfl_up(cf, o), ub = __shfl_down(cb, o);
        if (lane >= o) cf += uf;
        if (lane + o < 64) cb += ub;
    }
    gt[lane] = cf; gt[64 + lane] = pre[0]; gt[128 + lane] = cb; gt[192 + lane] = pre[1];
}
__device__ __forceinline__ void ml_conv8(const Args& a, int l, int b, int cc, int t, int col, float (&o)[8]) {
    const bf16_t* PML = (const bf16_t*)(a.ws + A_PML);
    const float* taps = a.in[I_CONVK] + (size_t)l * 9 * 512;
    const float* bias = a.in[I_CONVB] + l * 512;
    { const f32x4 b0 = *(const f32x4*)(bias + col), b1 = *(const f32x4*)(bias + col + 4); o[0] = b0.x; o[1] = b0.y; o[2] = b0.z; o[3] = b0.w; o[4] = b1.x; o[5] = b1.y; o[6] = b1.z; o[7] = b1.w; }
#pragma unroll
    for (int dy = 0; dy < 3; ++dy)
#pragma unroll
        for (int dx = 0; dx < 3; ++dx) {
            int nr; bool ok;
            if (cc >= 4) { const int ny = (cc - 4) + dy - 1, nx = t + dx - 1; ok = (ny >= 0) && (ny < 128) && (nx >= 0) && (nx < 64); nr = b * TL + ny * 64 + nx; }
            else { const int nt = cc * 64 + t + dx - 1; ok = (dy == 1) && (nt >= 0) && (nt < TC); nr = RLAT + b * TC + nt; }
            if (ok) {
                float v[8]; unpack8(*(const u32x4*)(PML + (size_t)nr * ML_COLS + col), v);
                const float* tp = taps + (dy * 3 + dx) * 512 + col;
                const f32x4 t0 = *(const f32x4*)tp, t1 = *(const f32x4*)(tp + 4);
                o[0] += t0.x * v[0]; o[1] += t0.y * v[1]; o[2] += t0.z * v[2]; o[3] += t0.w * v[3];
                o[4] += t1.x * v[4]; o[5] += t1.y * v[5]; o[6] += t1.z * v[6]; o[7] += t1.w * v[7];
            }
        }
}
constexpr int ML_LD = 72;
__device__ __forceinline__ void ml_fill_vt(const Args& a, int h, int row0, LAS bf16_t* VT, int tid, int lane, int wave) {
    const bf16_t* PML = (const bf16_t*)(a.ws + A_PML);
#pragma unroll
    for (int i = 0; i < 2; ++i) {
        const int eg = wave * 2 + i;
        const u32x4 w = *(const u32x4*)(PML + (size_t)(row0 + lane) * ML_COLS + 512 + h * 128 + eg * 8);
        LAS bf16_t* d = VT + (eg * 8) * ML_LD + lane;
        d[0 * ML_LD] = (bf16_t)(w.x & 0xffffu); d[1 * ML_LD] = (bf16_t)(w.x >> 16); d[2 * ML_LD] = (bf16_t)(w.y & 0xffffu); d[3 * ML_LD] = (bf16_t)(w.y >> 16);
        d[4 * ML_LD] = (bf16_t)(w.z & 0xffffu); d[5 * ML_LD] = (bf16_t)(w.z >> 16); d[6 * ML_LD] = (bf16_t)(w.w & 0xffffu); d[7 * ML_LD] = (bf16_t)(w.w >> 16);
    }
    for (int i = tid; i < 16 * 64; i += 512) { const int rr = i >> 6, s = i & 63; VT[(128 + rr) * ML_LD + s] = (rr == 0) ? (bf16_t)0x3F80 : (bf16_t)0; }
}

__device__ __forceinline__ void phase_ml_a(const Args& a, int l, LAS unsigned char* lds, int tid, int lane, int wave) {
    LAS bf16_t* KTF = (LAS bf16_t*)lds;
    LAS bf16_t* KTB = KTF + 64 * ML_LD;
    LAS bf16_t* VT = KTB + 64 * ML_LD;
    LAS float* gt = (LAS float*)(VT + 144 * ML_LD);
    float* DC = (float*)(a.ws + A_DC); float* DN = (float*)(a.ws + A_DN); float* GG = (float*)(a.ws + A_G);
    const int fr = lane & 15, fq = lane >> 4;
    for (int item = blockIdx.x; item < NBATCH * ML_H * NCH; item += gridDim.x) {
        const int b = item / (ML_H * NCH), rem = item % (ML_H * NCH), h = rem / NCH, cc = rem % NCH;
        const int row0 = chunk_row0(b, cc);
        if (wave == 0) {
            ml_gates(a, l, h, row0, gt, lane);
            const float cf = gt[lane], cb = gt[128 + lane];
            const float cfl = __shfl(cf, 63), cb0 = __shfl(cb, 0);
            gt[256 + lane] = __expf(cfl - cf + gt[64 + lane]);
            gt[320 + lane] = __expf(cb0 - cb + gt[192 + lane]);
            if (lane == 0) {
                GG[((b * ML_H + h) * 2 + 0) * NCH + cc] = __expf(cfl);
                GG[((b * ML_H + h) * 2 + 1) * NCH + cc] = __expf(cb0);
            }
        }
        ml_fill_vt(a, h, row0, VT, tid, lane, wave);
        float kc[8];
        ml_conv8(a, l, b, cc, lane, 256 + h * 64 + wave * 8, kc);
        __syncthreads();
        {
            const float wf = gt[256 + lane] * 0.125f, wb = gt[320 + lane] * 0.125f;
#pragma unroll
            for (int j = 0; j < 8; ++j) { KTF[(wave * 8 + j) * ML_LD + lane] = (bf16_t)f2bf(kc[j] * wf); KTB[(wave * 8 + j) * ML_LD + lane] = (bf16_t)f2bf(kc[j] * wb); }
        }
        __syncthreads();
        for (int idx = wave; idx < 72; idx += 8) {
            const int dir = idx / 36, r2 = idx % 36, dt = r2 / 9, et = r2 % 9;
            f32x4 acc = {0.f, 0.f, 0.f, 0.f};
            acc = lds_mma<2>(dir ? KTB : KTF, ML_LD, dt * 16, VT, ML_LD, et * 16, acc, fr, fq);
            const size_t ci = (size_t)((b * ML_H + h) * 2 + dir) * NCH + cc;
            const int d = dt * 16 + fr;
            if (et < 8) *(f32x4*)(DC + ci * 8192 + d * 128 + et * 16 + 4 * fq) = acc;
            else if (fq == 0) DN[ci * 64 + d] = acc[0];
        }
        __syncthreads();
    }
}
__device__ __forceinline__ int ml_seq_cc(int dir, int i) { return dir ? (i < 4 ? 3 - i : 135 - i) : i; }
__device__ __forceinline__ void phase_ml_b(const Args& a, int tid) {
    float* DC = (float*)(a.ws + A_DC); float* DN = (float*)(a.ws + A_DN); const float* GG = (const float*)(a.ws + A_G);
    const int nthreads = gridDim.x * 512;
    for (int e = blockIdx.x * 512 + tid; e < 16 * 8192 + 16 * 64; e += nthreads) {
        int chain, elem, stride; float* base;
        if (e < 16 * 8192) { chain = e >> 13; elem = e & 8191; stride = 8192; base = DC + (size_t)chain * NCH * 8192 + elem; }
        else { const int e2 = e - 16 * 8192; chain = e2 >> 6; elem = e2 & 63; stride = 64; base = DN + (size_t)chain * NCH * 64 + elem; }
        const int dir = chain & 1;
        const float* g = GG + chain * NCH;
        float C = 0.f;
        for (int i0 = 0; i0 < NCH; i0 += 12) {
            float tv[12], gv[12];
#pragma unroll
            for (int j = 0; j < 12; ++j) { const int cc = ml_seq_cc(dir, i0 + j); tv[j] = base[(size_t)cc * stride]; gv[j] = g[cc]; }
#pragma unroll
            for (int j = 0; j < 12; ++j) { const int cc = ml_seq_cc(dir, i0 + j); base[(size_t)cc * stride] = C; C = gv[j] * C + tv[j]; }
        }
    }
}
__device__ __forceinline__ void phase_ml_c(const Args& a, int l, bool need_ctx, LAS unsigned char* lds, int tid, int lane, int wave) {
    LAS bf16_t* Q = (LAS bf16_t*)lds;
    LAS bf16_t* K = Q + 64 * ML_LD;
    LAS bf16_t* QF = K + 64 * ML_LD;
    LAS bf16_t* QB = QF + 64 * ML_LD;
    LAS bf16_t* SF = QB + 64 * ML_LD;
    LAS bf16_t* SB = SF + 64 * ML_LD;
    LAS bf16_t* VT = SB + 64 * ML_LD;
    LAS bf16_t* CF = VT + 144 * ML_LD;
    LAS bf16_t* CB = CF + 144 * ML_LD;
    LAS float* gt = (LAS float*)(CB + 144 * ML_LD);
    LAS float* red = gt + 256;
    const float* DC = (const float*)(a.ws + A_DC); const float* DN = (const float*)(a.ws + A_DN);
    const bf16_t* PML = (const bf16_t*)(a.ws + A_PML);
    bf16_t* AL = (bf16_t*)(a.ws + A_ALAT);
    const float* ng = a.in[I_MLNG] + l * 512;
    const int fr = lane & 15, fq = lane >> 4;
    for (int item = blockIdx.x; item < NBATCH * ML_H * NCH; item += gridDim.x) {
        const int b = item / (ML_H * NCH), rem = item % (ML_H * NCH), h = rem / NCH, cc = rem % NCH;
        if (cc < 4 && !need_ctx) continue;
        const int row0 = chunk_row0(b, cc);
        if (wave == 0) ml_gates(a, l, h, row0, gt, lane);
#pragma unroll
        for (int i = 0; i < 2; ++i) {
            const int g = tid + 512 * i, t = g >> 4, cg = g & 15;
            const int col = (cg < 8) ? (h * 64 + cg * 8) : (256 + h * 64 + (cg - 8) * 8);
            float o[8]; ml_conv8(a, l, b, cc, t, col, o);
            const float sc = (cg < 8) ? 1.0f : 0.125f;
            u32x4 w; w.x = pk2(o[0] * sc, o[1] * sc); w.y = pk2(o[2] * sc, o[3] * sc); w.z = pk2(o[4] * sc, o[5] * sc); w.w = pk2(o[6] * sc, o[7] * sc);
            *(LAS u32x4*)(((cg < 8) ? Q : K) + t * ML_LD + (cg & 7) * 8) = w;
        }
        ml_fill_vt(a, h, row0, VT, tid, lane, wave);
#pragma unroll
        for (int dir = 0; dir < 2; ++dir) {
            const size_t ci = (size_t)((b * ML_H + h) * 2 + dir) * NCH + cc;
            LAS bf16_t* CT = dir ? CB : CF;
            const float* src = DC + ci * 8192 + lane * 128 + wave * 16;
#pragma unroll
            for (int q4 = 0; q4 < 4; ++q4) {
                const f32x4 v = *(const f32x4*)(src + q4 * 4);
                LAS bf16_t* d = CT + (wave * 16 + q4 * 4) * ML_LD + lane;
                d[0] = (bf16_t)f2bf(v.x); d[ML_LD] = (bf16_t)f2bf(v.y); d[2 * ML_LD] = (bf16_t)f2bf(v.z); d[3 * ML_LD] = (bf16_t)f2bf(v.w);
            }
            for (int i = tid; i < 16 * 64; i += 512) { const int rr = i >> 6, dd = i & 63; CT[(128 + rr) * ML_LD + dd] = (rr == 0) ? (bf16_t)f2bf(DN[ci * 64 + dd]) : (bf16_t)0; }
        }
        __syncthreads();
        {
            const int tt = wave >> 1;
#pragma unroll
            for (int i = 0; i < 2; ++i) {
                const int st = (wave & 1) * 2 + i;
                f32x4 acc = {0.f, 0.f, 0.f, 0.f};
                acc = lds_mma<2>(Q, ML_LD, tt * 16, K, ML_LD, st * 16, acc, fr, fq);
                const int t = tt * 16 + fr, s0 = st * 16 + 4 * fq;
                const float bft = gt[t], bbt = gt[128 + t];
                float sf[4], sb[4];
#pragma unroll
                for (int r = 0; r < 4; ++r) {
                    const int s = s0 + r;
                    sf[r] = (s <= t) ? acc[r] * __expf(bft - gt[s] + gt[64 + s]) : 0.f;
                    sb[r] = (s >= t) ? acc[r] * __expf(bbt - gt[128 + s] + gt[192 + s]) : 0.f;
                }
                u32x2 w; w.x = pk2(sf[0], sf[1]); w.y = pk2(sf[2], sf[3]); *(LAS u32x2*)(SF + t * ML_LD + s0) = w;
                w.x = pk2(sb[0], sb[1]); w.y = pk2(sb[2], sb[3]); *(LAS u32x2*)(SB + t * ML_LD + s0) = w;
            }
            const int t = tid >> 3, dg = tid & 7;
            float qv[8]; unpack8(*(const LAS u32x4*)(Q + t * ML_LD + dg * 8), qv);
            const float ef = __expf(gt[t]), eb = __expf(gt[128 + t]);
            u32x4 w; w.x = pk2(qv[0] * ef, qv[1] * ef); w.y = pk2(qv[2] * ef, qv[3] * ef); w.z = pk2(qv[4] * ef, qv[5] * ef); w.w = pk2(qv[6] * ef, qv[7] * ef);
            *(LAS u32x4*)(QF + t * ML_LD + dg * 8) = w;
            w.x = pk2(qv[0] * eb, qv[1] * eb); w.y = pk2(qv[2] * eb, qv[3] * eb); w.z = pk2(qv[4] * eb, qv[5] * eb); w.w = pk2(qv[6] * eb, qv[7] * eb);
            *(LAS u32x4*)(QB + t * ML_LD + dg * 8) = w;
        }
        __syncthreads();
        const int tt = wave >> 1, eh = wave & 1;
        float hs[4][4];
        {
            f32x4 af[5], ab[5];
#pragma unroll
            for (int i = 0; i < 5; ++i) {
                const int et = (i < 4) ? (eh * 4 + i) : 8;
                f32x4 z = {0.f, 0.f, 0.f, 0.f};
                af[i] = lds_mma<2>(QF, ML_LD, tt * 16, CF, ML_LD, et * 16, z, fr, fq);
                af[i] = lds_mma<2>(SF, ML_LD, tt * 16, VT, ML_LD, et * 16, af[i], fr, fq);
                ab[i] = lds_mma<2>(QB, ML_LD, tt * 16, CB, ML_LD, et * 16, z, fr, fq);
                ab[i] = lds_mma<2>(SB, ML_LD, tt * 16, VT, ML_LD, et * 16, ab[i], fr, fq);
            }
            const float denf = __shfl(af[4][0], fr), denb = __shfl(ab[4][0], fr);
            const float rf = 1.0f / fmaxf(fabsf(denf), 1.0f), rb = 1.0f / fmaxf(fabsf(denb), 1.0f);
            float ss = 0.f;
#pragma unroll
            for (int i = 0; i < 4; ++i)
#pragma unroll
                for (int r = 0; r < 4; ++r) { const float v = af[i][r] * rf + ab[i][r] * rb; hs[i][r] = v; ss += v * v; }
            ss += __shfl_xor(ss, 16); ss += __shfl_xor(ss, 32);
            if (fq == 0) red[(tt * 16 + fr) * 2 + eh] = ss;
        }
        __syncthreads();
        {
            const int t = tt * 16 + fr;
            const float tot = red[t * 2] + red[t * 2 + 1];
            const float rinv = rsqrtf(tot * (1.0f / 128.0f) + NORM_EPS);
            const int row = row0 + t;
#pragma unroll
            for (int i = 0; i < 4; ++i) {
                const int col = h * 128 + (eh * 4 + i) * 16 + 4 * fq;
                float ov[4]; unpack4(*(const u32x2*)(PML + (size_t)row * ML_COLS + 1024 + col), ov);
                const f32x4 g4 = *(const f32x4*)(ng + col);
                u32x2 w;
                w.x = pk2(hs[i][0] * rinv * g4.x * sigmoidf_(ov[0]), hs[i][1] * rinv * g4.y * sigmoidf_(ov[1]));
                w.y = pk2(hs[i][2] * rinv * g4.z * sigmoidf_(ov[2]), hs[i][3] * rinv * g4.w * sigmoidf_(ov[3]));
                *(u32x2*)(AL + (size_t)row * 512 + col) = w;
            }
        }
        __syncthreads();
    }
}

__device__ __forceinline__ void rw_seq_bounds(int r, bool& hasp, bool& hasn) {
    int t, len;
    if (r < RLAT) { t = r & (TL - 1); len = TL; } else { t = (r - RLAT) & (TC - 1); len = TC; }
    hasp = t > 0; hasn = t < len - 1;
}
__device__ __forceinline__ void rw_shift8(const bf16_t* __restrict__ PRW, const float* __restrict__ mu, int r, bool hasp, bool hasn, int col, float (&o)[8]) {
    const bf16_t* p = PRW + (size_t)r * RW_COLS + col;
    float c[8], pv[8], nv[8];
    const float wp = hasp ? 0.5f : 0.f, wn = hasn ? 0.5f : 0.f;
    unpack8(*(const u32x4*)p, c);
    unpack8(*(const u32x4*)(p - (hasp ? RW_COLS : 0)), pv);
    unpack8(*(const u32x4*)(p + (hasn ? RW_COLS : 0)), nv);
    const f32x4 m0 = *(const f32x4*)(mu + col), m1 = *(const f32x4*)(mu + col + 4);
    const float m[8] = {m0.x, m0.y, m0.z, m0.w, m1.x, m1.y, m1.z, m1.w};
#pragma unroll
    for (int j = 0; j < 8; ++j) o[j] = c[j] + m[j] * (wp * pv[j] + wn * nv[j] - c[j]);
}
__device__ __forceinline__ void rw_shift4(const bf16_t* __restrict__ PRW, const float* __restrict__ mu, int r, bool hasp, bool hasn, int col, float (&o)[4]) {
    const bf16_t* p = PRW + (size_t)r * RW_COLS + col;
    float c[4], pv[4], nv[4];
    const float wp = hasp ? 0.5f : 0.f, wn = hasn ? 0.5f : 0.f;
    unpack4(*(const u32x2*)p, c);
    unpack4(*(const u32x2*)(p - (hasp ? RW_COLS : 0)), pv);
    unpack4(*(const u32x2*)(p + (hasn ? RW_COLS : 0)), nv);
    const f32x4 m0 = *(const f32x4*)(mu + col);
    const float m[4] = {m0.x, m0.y, m0.z, m0.w};
#pragma unroll
    for (int j = 0; j < 4; ++j) o[j] = c[j] + m[j] * (wp * pv[j] + wn * nv[j] - c[j]);
}
__device__ __forceinline__ bf16x8 pack_frag(const float (&v)[8]) {
    u32x4 w; w.x = pk2(v[0], v[1]); w.y = pk2(v[2], v[3]); w.z = pk2(v[4], v[5]); w.w = pk2(v[6], v[7]);
    return __builtin_bit_cast(bf16x8, w);
}
__device__ __forceinline__ void phase_rw_prep(const Args& a, int l, int lane, int gw, int nw) {
    const bf16_t* PRW = (const bf16_t*)(a.ws + A_PRW);
    const float* mu = a.in[I_MU] + l * RW_COLS;
    const bf16_t* WUP = (const bf16_t*)(a.ws + WS_WUP); const bf16_t* AUP = (const bf16_t*)(a.ws + WS_AUP); const bf16_t* GUP = (const bf16_t*)(a.ws + WS_GUP);
    const float* w0 = a.in[I_W0] + l * 2 * 512; const float* a0 = a.in[I_A0] + l * 2 * 512;
    const float* k_k = a.in[I_KK] + l * 512; const float* k_a = a.in[I_KA] + l * 512; const float* r_k = a.in[I_RK] + l * 512;
    bf16_t* S_OMW[2] = {(bf16_t*)(a.ws + A_SOMW0), (bf16_t*)(a.ws + A_SOMW1)};
    bf16_t* S_KKA[2] = {(bf16_t*)(a.ws + A_SKKA0), (bf16_t*)(a.ws + A_SKKA1)};
    bf16_t* S_KD[2] = {(bf16_t*)(a.ws + A_SKD0), (bf16_t*)(a.ws + A_SKD1)};
    bf16_t* S_KK = (bf16_t*)(a.ws + A_SKK); bf16_t* S_R = (bf16_t*)(a.ws + A_SR); bf16_t* S_V = (bf16_t*)(a.ws + A_SV); bf16_t* S_G = (bf16_t*)(a.ws + A_SG);
    float* BON = (float*)(a.ws + A_BONUS);
    for (int item = gw; item < RT / 16; item += nw) {
        int lane_ = lane; asm volatile("" : "+v"(lane_));
        int fr = lane_ & 15, fq = lane_ >> 4;
        const int r = item * 16 + fr;
        bool hasp, hasn; rw_seq_bounds(r, hasp, hasn);
        bf16x8 fw[2][2], fa[2][2], fg[4];
#pragma unroll
        for (int d = 0; d < 2; ++d)
#pragma unroll
            for (int ks = 0; ks < 2; ++ks) {
                float v[8];
                rw_shift8(PRW, mu, r, hasp, hasn, 1536 + d * 64 + ks * 32 + fq * 8, v);
#pragma unroll
                for (int j = 0; j < 8; ++j) v[j] = tanhf_(v[j]);
                fw[d][ks] = pack_frag(v);
                __builtin_amdgcn_sched_barrier(0);
                rw_shift8(PRW, mu, r, hasp, hasn, 1664 + d * 64 + ks * 32 + fq * 8, v);
                fa[d][ks] = pack_frag(v);
                __builtin_amdgcn_sched_barrier(0);
            }
#pragma unroll
        for (int ks = 0; ks < 4; ++ks) {
            float v[8];
            rw_shift8(PRW, mu, r, hasp, hasn, 1792 + ks * 32 + fq * 8, v);
#pragma unroll
            for (int j = 0; j < 8; ++j) v[j] = sigmoidf_(v[j]);
            fg[ks] = pack_frag(v);
            __builtin_amdgcn_sched_barrier(0);
        }
#pragma unroll 1
        for (int hh = 0; hh < RW_H; ++hh) {
            asm volatile("" : "+v"(fq), "+v"(fr));
            float ss = 0.f;
#pragma unroll
            for (int nt = 0; nt < 4; ++nt) {
                const int c = hh * 64 + nt * 16 + 4 * fq;
                float kv[4]; rw_shift4(PRW, mu, r, hasp, hasn, 512 + c, kv);
                const f32x4 kk4 = *(const f32x4*)(k_k + c);
                const float q0 = kv[0] * kk4.x, q1 = kv[1] * kk4.y, q2 = kv[2] * kk4.z, q3 = kv[3] * kk4.w;
                ss += (q0 * q0 + q1 * q1) + (q2 * q2 + q3 * q3);
            }
            ss += __shfl_xor(ss, 16); ss += __shfl_xor(ss, 32);
            const float kn = rsqrtf(ss + 1e-12f);
            float bon = 0.f;
#pragma unroll 1
            for (int nt = 0; nt < 4; ++nt) {
                asm volatile("" : "+v"(fq), "+v"(fr));
                const int c0 = hh * 64 + nt * 16;
                f32x4 aw[2], aa[2], ag = {0.f, 0.f, 0.f, 0.f};
#pragma unroll
                for (int d = 0; d < 2; ++d) {
                    aw[d] = (f32x4){0.f, 0.f, 0.f, 0.f}; aa[d] = (f32x4){0.f, 0.f, 0.f, 0.f};
#pragma unroll
                    for (int ks = 0; ks < 2; ++ks) {
                        const bf16x8 bw = *(const bf16x8*)(WUP + (size_t)(d * 512 + c0 + fr) * 64 + ks * 32 + fq * 8);
                        const bf16x8 ba = *(const bf16x8*)(AUP + (size_t)(d * 512 + c0 + fr) * 64 + ks * 32 + fq * 8);
                        aw[d] = __builtin_amdgcn_mfma_f32_16x16x32_bf16(bw, fw[d][ks], aw[d], 0, 0, 0);
                        aa[d] = __builtin_amdgcn_mfma_f32_16x16x32_bf16(ba, fa[d][ks], aa[d], 0, 0, 0);
                    }
                }
#pragma unroll
                for (int ks = 0; ks < 4; ++ks) {
                    const bf16x8 bg = *(const bf16x8*)(GUP + (size_t)(c0 + fr) * 128 + ks * 32 + fq * 8);
                    ag = __builtin_amdgcn_mfma_f32_16x16x32_bf16(bg, fg[ks], ag, 0, 0, 0);
                }
                const int c = c0 + 4 * fq;
                float rv[4], kv[4], vv[4];
                rw_shift4(PRW, mu, r, hasp, hasn, c, rv);
                rw_shift4(PRW, mu, r, hasp, hasn, 512 + c, kv);
                rw_shift4(PRW, mu, r, hasp, hasn, 1024 + c, vv);
                const f32x4 kk4 = *(const f32x4*)(k_k + c), ka4 = *(const f32x4*)(k_a + c), rk4 = *(const f32x4*)(r_k + c);
                float kkv[4];
#pragma unroll
                for (int j = 0; j < 4; ++j) kkv[j] = kv[j] * kk4[j] * kn;
                const size_t o = (size_t)r * 512 + c;
                { u32x2 w; w.x = pk2(kkv[0], kkv[1]); w.y = pk2(kkv[2], kkv[3]); *(u32x2*)(S_KK + o) = w; }
                { u32x2 w; w.x = pk2(rv[0], rv[1]); w.y = pk2(rv[2], rv[3]); *(u32x2*)(S_R + o) = w; }
                { u32x2 w; w.x = pk2(vv[0], vv[1]); w.y = pk2(vv[2], vv[3]); *(u32x2*)(S_V + o) = w; }
                { u32x2 w; w.x = pk2(ag[0], ag[1]); w.y = pk2(ag[2], ag[3]); *(u32x2*)(S_G + o) = w; }
#pragma unroll
                for (int d = 0; d < 2; ++d) {
                    const f32x4 w04 = *(const f32x4*)(w0 + d * 512 + c), a04 = *(const f32x4*)(a0 + d * 512 + c);
                    float omw[4], kka[4], kd[4];
#pragma unroll
                    for (int j = 0; j < 4; ++j) {
                        const float lw = w04[j] + aw[d][j];
                        const float sp = softplusf_(-lw);
                        const float dx = __expf(-sp - 0.5f);
                        omw[j] = 1.0f - __expf(-dx);
                        const float av = sigmoidf_(a04[j] + aa[d][j]);
                        kka[j] = kkv[j] * av;
                        kd[j] = kv[j] * (1.0f + (av - 1.0f) * ka4[j]);
                        bon += rv[j] * kd[j] * rk4[j];
                    }
                    { u32x2 w; w.x = pk2(omw[0], omw[1]); w.y = pk2(omw[2], omw[3]); *(u32x2*)(S_OMW[d] + o) = w; }
                    { u32x2 w; w.x = pk2(kka[0], kka[1]); w.y = pk2(kka[2], kka[3]); *(u32x2*)(S_KKA[d] + o) = w; }
                    { u32x2 w; w.x = pk2(kd[0], kd[1]); w.y = pk2(kd[2], kd[3]); *(u32x2*)(S_KD[d] + o) = w; }
                }
            }
            bon += __shfl_xor(bon, 16); bon += __shfl_xor(bon, 32);
            if (fq == 0) BON[(size_t)r * 8 + hh] = bon;
        }
    }
}

__device__ __forceinline__ int rw_seq_row(int b, int dir, int i) {
    if (i < TC) return RLAT + b * TC + (dir ? TC - 1 - i : i);
    const int j = i - TC; return b * TL + (dir ? TL - 1 - j : j);
}
__device__ __forceinline__ int rw_seq_pos(int dir, int i) {
    if (i < TC) return dir ? TC - 1 - i : i;
    const int j = i - TC; return TC + (dir ? TL - 1 - j : j);
}
__device__ __forceinline__ void phase_rw_scan(const Args& a, LAS unsigned char* lds, int tid, int lane, int wave) {
    const bf16_t* SRC[6];
    bf16_t* Y = (bf16_t*)(a.ws + A_Y);
    for (int cw = blockIdx.x; cw < 256; cw += gridDim.x) {
        const int chain = cw >> 3, rowbase = (cw & 7) * 8;
        const int dir = chain & 1, hh = (chain >> 1) & 7, b = chain >> 4;
        SRC[0] = (const bf16_t*)(a.ws + (dir ? A_SOMW1 : A_SOMW0)); SRC[1] = (const bf16_t*)(a.ws + A_SKK); SRC[2] = (const bf16_t*)(a.ws + (dir ? A_SKKA1 : A_SKKA0));
        SRC[3] = (const bf16_t*)(a.ws + (dir ? A_SKD1 : A_SKD0)); SRC[4] = (const bf16_t*)(a.ws + A_SR); SRC[5] = (const bf16_t*)(a.ws + A_SV);
        const int row = rowbase + wave;
        bf16_t* yrow = Y + ((size_t)(dir * 16 + b * 8 + hh) * 64 + row) * SEQ;
        const int lstep = tid >> 3, lpart = tid & 7;
        u32x4 lr[6];
        {
            const int rr = rw_seq_row(b, dir, lstep);
#pragma unroll
            for (int s = 0; s < 6; ++s) lr[s] = *(const u32x4*)(SRC[s] + (size_t)rr * 512 + hh * 64 + lpart * 8);
#pragma unroll
            for (int s = 0; s < 6; ++s) *(LAS u32x4*)(lds + s * 8192 + lstep * 128 + lpart * 16) = lr[s];
        }
        __syncthreads();
        float S = 0.f;
        constexpr int NBLK = SEQ / 64;
        for (int blk = 0; blk < NBLK; ++blk) {
            LAS unsigned char* cur = lds + (blk & 1) * 49152;
            if (blk + 1 < NBLK) {
                const int rr = rw_seq_row(b, dir, (blk + 1) * 64 + lstep);
#pragma unroll
                for (int s = 0; s < 6; ++s) lr[s] = *(const u32x4*)(SRC[s] + (size_t)rr * 512 + hh * 64 + lpart * 8);
            }
            float ybuf = 0.f;
#pragma unroll 8
            for (int s = 0; s < 64; ++s) {
                const LAS bf16_t* p = (const LAS bf16_t*)cur + s * 64;
                const float omw = bf2f(p[lane]), kk = bf2f(p[4096 + lane]), kka = bf2f(p[2 * 4096 + lane]), kd = bf2f(p[3 * 4096 + lane]), rr_ = bf2f(p[4 * 4096 + lane]);
                const float v = bf2f(p[5 * 4096 + row]);
                const float sa = wave_sum_dpp(S * kk);
                S = fmaf(-omw, S, S);
                S = fmaf(v, kd, S);
                S = fmaf(-sa, kka, S);
                const float y = wave_sum_dpp(S * rr_);
                ybuf = (lane == s) ? y : ybuf;
            }
            yrow[rw_seq_pos(dir, blk * 64 + lane)] = (bf16_t)f2bf(ybuf);
            if (blk + 1 < NBLK) {
                LAS unsigned char* nxt = lds + ((blk + 1) & 1) * 49152;
#pragma unroll
                for (int s = 0; s < 6; ++s) *(LAS u32x4*)(nxt + s * 8192 + lstep * 128 + lpart * 16) = lr[s];
            }
            __syncthreads();
        }
    }
}

__device__ __forceinline__ void phase_rw_out(const Args& a, int l, bool need_ctx, int lane, int gw, int nw) {
    const bf16_t* Y = (const bf16_t*)(a.ws + A_Y);
    const bf16_t* S_V = (const bf16_t*)(a.ws + A_SV); const bf16_t* S_G = (const bf16_t*)(a.ws + A_SG);
    const float* BON = (const float*)(a.ws + A_BONUS);
    bf16_t* BL = (bf16_t*)(a.ws + A_BLAT);
    const float* lnw = a.in[I_LNW] + l * 512; const float* lnb = a.in[I_LNB] + l * 512;
    for (int item = gw; item < 16 * NCH; item += nw) {
        const int bh = item / NCH, pb = item % NCH, b = bh >> 3, hh = bh & 7;
        if (pb < 4 && !need_ctx) continue;
        const int pos = pb * 64 + lane;
        const int r = (pb < 4) ? RLAT + b * TC + pos : b * TL + (pos - TC);
        const bf16_t* yf = Y + ((size_t)(0 * 16 + bh) * 64) * SEQ + pos;
        const bf16_t* yb = Y + ((size_t)(1 * 16 + bh) * 64) * SEQ + pos;
        float y[64]; float s = 0.f;
#pragma unroll
        for (int i = 0; i < 64; ++i) { y[i] = bf2f(yf[(size_t)i * SEQ]) + bf2f(yb[(size_t)i * SEQ]); s += y[i]; }
        const float mean = s * (1.0f / 64.0f);
        float q = 0.f;
#pragma unroll
        for (int i = 0; i < 64; ++i) { const float d = y[i] - mean; q += d * d; }
        const float rstd = rsqrtf(q * (1.0f / 64.0f) + RW_GN_EPS);
        const float bon = BON[(size_t)r * 8 + hh];
        const size_t o = (size_t)r * 512 + hh * 64;
#pragma unroll
        for (int c8 = 0; c8 < 8; ++c8) {
            float vv[8], gg[8];
            unpack8(*(const u32x4*)(S_V + o + c8 * 8), vv); unpack8(*(const u32x4*)(S_G + o + c8 * 8), gg);
            const f32x4 w0 = *(const f32x4*)(lnw + hh * 64 + c8 * 8), w1 = *(const f32x4*)(lnw + hh * 64 + c8 * 8 + 4);
            const f32x4 b0 = *(const f32x4*)(lnb + hh * 64 + c8 * 8), b1 = *(const f32x4*)(lnb + hh * 64 + c8 * 8 + 4);
            const float lw[8] = {w0.x, w0.y, w0.z, w0.w, w1.x, w1.y, w1.z, w1.w}, lb[8] = {b0.x, b0.y, b0.z, b0.w, b1.x, b1.y, b1.z, b1.w};
            float ov[8];
#pragma unroll
            for (int j = 0; j < 8; ++j) ov[j] = ((y[c8 * 8 + j] - mean) * rstd * lw[j] + lb[j] + bon * vv[j]) * gg[j];
            u32x4 w; w.x = pk2(ov[0], ov[1]); w.y = pk2(ov[2], ov[3]); w.z = pk2(ov[4], ov[5]); w.w = pk2(ov[6], ov[7]);
            *(u32x4*)(BL + o + c8 * 8) = w;
        }
    }
}

__device__ __forceinline__ void phase_merge1(const Args& a, bool need_ctx, LAS unsigned char* lds, int tid, int lane, int wave) {
    LAS bf16_t* sm = (LAS bf16_t*)lds;
    const bf16_t* AL = (const bf16_t*)(a.ws + A_ALAT); const bf16_t* BL = (const bf16_t*)(a.ws + A_BLAT);
    const bf16_t* WPA = (const bf16_t*)(a.ws + WS_WPA); const bf16_t* WPB = (const bf16_t*)(a.ws + WS_WPB);
    const bf16_t* PGT = (const bf16_t*)(a.ws + A_PGT);
    bf16_t* U = (bf16_t*)(a.ws + A_U);
    const int wm = wave >> 2, wn = wave & 3, fr = lane & 15, fq = lane >> 4;
    const int srow = tid >> 3, skc = tid & 7;
    const int NM = (need_ctx ? RT : RLAT) / 128;
    for (int tile = blockIdx.x; tile < NM * 8; tile += gridDim.x) {
        const int tm = tile >> 3, tn = tile & 7;
        f32x4 acc[4][2], acc2[4][2]; ZERO_ACC(acc); ZERO_ACC(acc2);
        {
            const bf16_t* pa0 = AL + (size_t)(tm * 128 + srow) * 512 + skc * 8;
            const bf16_t* pb0 = WPA + (size_t)(tn * 128 + srow) * 512 + skc * 8;
            gemm_tile(sm, pa0, pa0 + (size_t)64 * 512, pb0, pb0 + (size_t)64 * 512, 8, acc, tid, lane, wm, wn);
        }
        {
            const bf16_t* pa0 = BL + (size_t)(tm * 128 + srow) * 512 + skc * 8;
            const bf16_t* pb0 = WPB + (size_t)(tn * 128 + srow) * 512 + skc * 8;
            gemm_tile(sm, pa0, pa0 + (size_t)64 * 512, pb0, pb0 + (size_t)64 * 512, 8, acc2, tid, lane, wm, wn);
        }
#pragma unroll
        for (int mi = 0; mi < 4; ++mi) {
            const int row = tm * 128 + wm * 64 + mi * 16 + fr;
#pragma unroll
            for (int ni = 0; ni < 2; ++ni) {
                const int nc = tn * 128 + wn * 32 + ni * 16 + 4 * fq;
                float ga[4], gb[4];
                unpack4(*(const u32x2*)(PGT + (size_t)row * GT_COLS + nc), ga);
                unpack4(*(const u32x2*)(PGT + (size_t)row * GT_COLS + 1024 + nc), gb);
                float o[4];
#pragma unroll
                for (int j = 0; j < 4; ++j) o[j] = sigmoidf_(ga[j]) * acc[mi][ni][j] + sigmoidf_(gb[j]) * acc2[mi][ni][j];
                u32x2 w; w.x = pk2(o[0], o[1]); w.y = pk2(o[2], o[3]);
                *(u32x2*)(U + (size_t)row * D + nc) = w;
            }
        }
    }
}
__device__ __forceinline__ void phase_merge2(const Args& a, int l, bool need_ctx, LAS unsigned char* lds, int tid, int lane, int wave) {
    LAS bf16_t* sm = (LAS bf16_t*)lds;
    const bf16_t* U = (const bf16_t*)(a.ws + A_U); const bf16_t* WO = (const bf16_t*)(a.ws + WS_WOUT);
    const float* MOD = (const float*)(a.ws + WS_MOD);
    const int wm = wave >> 2, wn = wave & 3, fr = lane & 15, fq = lane >> 4;
    const int srow = tid >> 3, skc = tid & 7;
    const int NM = (need_ctx ? RT : RLAT) / 128;
    for (int tile = blockIdx.x; tile < NM * 8; tile += gridDim.x) {
        const int tm = tile >> 3, tn = tile & 7;
        f32x4 acc[4][2]; ZERO_ACC(acc);
        const bf16_t* pa0 = U + (size_t)(tm * 128 + srow) * D + skc * 8;
        const bf16_t* pb0 = WO + (size_t)(tn * 128 + srow) * D + skc * 8;
        gemm_tile(sm, pa0, pa0 + (size_t)64 * D, pb0, pb0 + (size_t)64 * D, 16, acc, tid, lane, wm, wn);
#pragma unroll
        for (int mi = 0; mi < 4; ++mi) {
            const int row = tm * 128 + wm * 64 + mi * 16 + fr;
            const float* g1 = MOD + ((size_t)l * 3 + row_mv(row)) * 6144 + 2048;
            const float* xi = xrow_in(a, l, row); float* xo = xrow_out(a, row);
#pragma unroll
            for (int ni = 0; ni < 2; ++ni) {
                const int nc = tn * 128 + wn * 32 + ni * 16 + 4 * fq;
                const f32x4 g = *(const f32x4*)(g1 + nc), x = *(const f32x4*)(xi + nc);
                f32x4 o; o.x = x.x + g.x * acc[mi][ni][0]; o.y = x.y + g.y * acc[mi][ni][1]; o.z = x.z + g.z * acc[mi][ni][2]; o.w = x.w + g.w * acc[mi][ni][3];
                *(f32x4*)(xo + nc) = o;
            }
        }
    }
}

__device__ __forceinline__ void phase_router(const Args& a, int l, bool need_ctx, LAS unsigned char* lds, int tid, int lane, int gw, int nw) {
    LAS float* Wt = (LAS float*)lds;
    for (int i = tid; i < 16 * 1024; i += 512) { const int k = i >> 4, e = i & 15; Wt[e * 1024 + k] = a.in[I_RTW][i]; }
    __syncthreads();
    const float* MOD = (const float*)(a.ws + WS_MOD);
    bf16_t* H2 = (bf16_t*)(a.ws + A_H2);
    unsigned* cnt = (unsigned*)(a.ws + WS_CTL) + CW_CNT + l * 16;
    int* LIST = (int*)(a.ws + A_LIST); float* TOKW = (float*)(a.ws + A_TOKW);
    const int nrows = need_ctx ? RT : RLAT;
    for (int r = gw; r < nrows; r += nw) {
        const float* xr = (r < RLAT) ? a.out + (size_t)r * D : (const float*)(a.ws + WS_XCTX) + (size_t)(r - RLAT) * D;
        f32x4 v[4], h[4];
#pragma unroll
        for (int j = 0; j < 4; ++j) v[j] = *(const f32x4*)(xr + 4 * lane + 256 * j);
        const float* m = MOD + ((size_t)l * 3 + row_mv(r)) * 6144;
        norm_mod_row(v, a.in[I_N2G] + l * D, m + 3072, m + 4096, H2 + (size_t)r * D, lane, h);
        int i1 = 0, i2 = 0; float c1 = 0.f, c2 = 0.f, bestv = -1e30f;
#pragma unroll 1
        for (int g = 0; g < 4; ++g) {
            float m1 = -1e30f, m2 = -1e30f, q1 = 0.f, q2 = 0.f; int j1 = 0, j2 = 0;
#pragma unroll
            for (int jj = 0; jj < 4; ++jj) {
                const int e = g * 4 + jj;
                float p = 0.f;
#pragma unroll
                for (int j = 0; j < 4; ++j) { const f32x4 w = *(const LAS f32x4*)(Wt + e * 1024 + 256 * j + 4 * lane); p += (h[j].x * w.x + h[j].y * w.y) + (h[j].z * w.z + h[j].w * w.w); }
                const float sc = sigmoidf_(wave_sum_dpp(p));
                const float x = sc + a.in[I_RTB][e];
                if (x > m1) { m2 = m1; j2 = j1; q2 = q1; m1 = x; j1 = e; q1 = sc; } else if (x > m2) { m2 = x; j2 = e; q2 = sc; }
            }
            const float gs = m1 + m2;
            if (gs > bestv) { bestv = gs; i1 = j1; i2 = j2; c1 = q1; c2 = q2; }
        }
        if (lane == 0) {
            const float inv = 1.0f / (c1 + c2);
            const unsigned p1 = atomicAdd(cnt + i1, 1u); LIST[(size_t)i1 * RT + p1] = r * 2;
            const unsigned p2 = atomicAdd(cnt + i2, 1u); LIST[(size_t)i2 * RT + p2] = r * 2 + 1;
            TOKW[(size_t)r * 2] = c1 * inv; TOKW[(size_t)r * 2 + 1] = c2 * inv;
        }
    }
}

__device__ __forceinline__ void moe_counts(const Args& a, int l, int (&cn)[16], int (&base)[16], int (&mtc)[17]) {
    const unsigned* cnt = (const unsigned*)(a.ws + WS_CTL) + CW_CNT + l * 16;
    int s = 0, t = 0;
#pragma unroll
    for (int e = 0; e < 16; ++e) { cn[e] = (int)__hip_atomic_load(cnt + e, __ATOMIC_RELAXED, __HIP_MEMORY_SCOPE_AGENT); base[e] = s; s += cn[e]; mtc[e] = t; t += (cn[e] + 127) >> 7; }
    mtc[16] = t;
}
__device__ __forceinline__ void phase_moe_up(const Args& a, int l, LAS unsigned char* lds, int tid, int lane, int wave) {
    LAS bf16_t* sm = (LAS bf16_t*)lds;
    int cn[16], base[16], mtc[17]; moe_counts(a, l, cn, base, mtc);
    const int* LIST = (const int*)(a.ws + A_LIST);
    const bf16_t* H2 = (const bf16_t*)(a.ws + A_H2);
    const bf16_t* WG = (const bf16_t*)(a.ws + A_WG); const bf16_t* WU = (const bf16_t*)(a.ws + A_WU);
    bf16_t* HID = (bf16_t*)(a.ws + A_HID);
    const int wm = wave >> 2, wn = wave & 3, fr = lane & 15, fq = lane >> 4;
    const int srow = tid >> 3, skc = tid & 7;
    const int ntile = mtc[16] * 4;
    for (int tile = blockIdx.x; tile < ntile; tile += gridDim.x) {
        const int mtg = tile >> 2, tn = tile & 3;
        int e = 0;
#pragma unroll
        for (int i = 1; i < 16; ++i) if (mtg >= mtc[i]) e = i;
        int cne = 0, be = 0, mt0 = 0;
#pragma unroll
        for (int i = 0; i < 16; ++i) if (i == e) { cne = cn[i]; be = base[i]; mt0 = mtc[i]; }
        const int m0 = (mtg - mt0) * 128;
        const int i0 = min(m0 + srow, cne - 1), i1 = min(m0 + srow + 64, cne - 1);
        const int tok0 = LIST[(size_t)e * RT + i0] >> 1, tok1 = LIST[(size_t)e * RT + i1] >> 1;
        const bf16_t* pa0 = H2 + (size_t)tok0 * D + skc * 8;
        const bf16_t* pa1 = H2 + (size_t)tok1 * D + skc * 8;
        f32x4 acc[4][2], acc2[4][2]; ZERO_ACC(acc); ZERO_ACC(acc2);
        {
            const bf16_t* pb0 = WG + ((size_t)e * DE + tn * 128 + srow) * D + skc * 8;
            gemm_tile(sm, pa0, pa1, pb0, pb0 + (size_t)64 * D, 16, acc, tid, lane, wm, wn);
        }
        {
            const bf16_t* pb0 = WU + ((size_t)e * DE + tn * 128 + srow) * D + skc * 8;
            gemm_tile(sm, pa0, pa1, pb0, pb0 + (size_t)64 * D, 16, acc2, tid, lane, wm, wn);
        }
#pragma unroll
        for (int mi = 0; mi < 4; ++mi) {
            const int li = m0 + wm * 64 + mi * 16 + fr;
            if (li < cne) {
#pragma unroll
                for (int ni = 0; ni < 2; ++ni) {
                    const int nc = tn * 128 + wn * 32 + ni * 16 + 4 * fq;
                    float o[4];
#pragma unroll
                    for (int j = 0; j < 4; ++j) o[j] = siluf_(acc[mi][ni][j]) * acc2[mi][ni][j];
                    u32x2 w; w.x = pk2(o[0], o[1]); w.y = pk2(o[2], o[3]);
                    *(u32x2*)(HID + (size_t)(be + li) * DE + nc) = w;
                }
            }
        }
    }
}
__device__ __forceinline__ void phase_moe_down(const Args& a, int l, LAS unsigned char* lds, int tid, int lane, int wave) {
    LAS bf16_t* sm = (LAS bf16_t*)lds;
    int cn[16], base[16], mtc[17]; moe_counts(a, l, cn, base, mtc);
    const int* LIST = (const int*)(a.ws + A_LIST); const float* TOKW = (const float*)(a.ws + A_TOKW);
    const bf16_t* HID = (const bf16_t*)(a.ws + A_HID); const bf16_t* WD = (const bf16_t*)(a.ws + A_WD);
    bf16_t* CON = (bf16_t*)(a.ws + A_CONTRIB);
    const int wm = wave >> 2, wn = wave & 3, fr = lane & 15, fq = lane >> 4;
    const int srow = tid >> 3, skc = tid & 7;
    const int ntile = mtc[16] * 8;
    for (int tile = blockIdx.x; tile < ntile; tile += gridDim.x) {
        const int mtg = tile >> 3, tn = tile & 7;
        int e = 0;
#pragma unroll
        for (int i = 1; i < 16; ++i) if (mtg >= mtc[i]) e = i;
        int cne = 0, be = 0, mt0 = 0;
#pragma unroll
        for (int i = 0; i < 16; ++i) if (i == e) { cne = cn[i]; be = base[i]; mt0 = mtc[i]; }
        const int m0 = (mtg - mt0) * 128;
        const int i0 = min(m0 + srow, cne - 1), i1 = min(m0 + srow + 64, cne - 1);
        const bf16_t* pa0 = HID + (size_t)(be + i0) * DE + skc * 8;
        const bf16_t* pa1 = HID + (size_t)(be + i1) * DE + skc * 8;
        const bf16_t* pb0 = WD + ((size_t)e * D + tn * 128 + srow) * DE + skc * 8;
        f32x4 acc[4][2]; ZERO_ACC(acc);
        gemm_tile(sm, pa0, pa1, pb0, pb0 + (size_t)64 * DE, 8, acc, tid, lane, wm, wn);
#pragma unroll
        for (int mi = 0; mi < 4; ++mi) {
            const int li = m0 + wm * 64 + mi * 16 + fr;
            if (li < cne) {
                const int ent = LIST[(size_t)e * RT + li];
                const float w = TOKW[ent];
                bf16_t* dst = CON + ((size_t)(ent & 1) * RT + (ent >> 1)) * D;
#pragma unroll
                for (int ni = 0; ni < 2; ++ni) {
                    const int nc = tn * 128 + wn * 32 + ni * 16 + 4 * fq;
                    u32x2 o; o.x = pk2(w * acc[mi][ni][0], w * acc[mi][ni][1]); o.y = pk2(w * acc[mi][ni][2], w * acc[mi][ni][3]);
                    *(u32x2*)(dst + nc) = o;
                }
            }
        }
    }
}
__device__ __forceinline__ void phase_combine(const Args& a, int l, bool need_ctx, bool last, int lane, int gw, int nw) {
    const float* MOD = (const float*)(a.ws + WS_MOD);
    const bf16_t* CON = (const bf16_t*)(a.ws + A_CONTRIB);
    bf16_t* H = (bf16_t*)(a.ws + A_H);
    const int nrows = need_ctx ? RT : RLAT;
    for (int r = gw; r < nrows; r += nw) {
        float* xr = xrow_out(a, r);
        const float* g2 = MOD + ((size_t)l * 3 + row_mv(r)) * 6144 + 5120;
        f32x4 v[4];
#pragma unroll
        for (int j = 0; j < 4; ++j) {
            const int idx = 4 * lane + 256 * j;
            v[j] = *(const f32x4*)(xr + idx);
            float c0[4], c1[4];
            unpack4(*(const u32x2*)(CON + (size_t)r * D + idx), c0); unpack4(*(const u32x2*)(CON + ((size_t)RT + r) * D + idx), c1);
            const f32x4 g = *(const f32x4*)(g2 + idx);
            v[j].x += g.x * (c0[0] + c1[0]); v[j].y += g.y * (c0[1] + c1[1]); v[j].z += g.z * (c0[2] + c1[2]); v[j].w += g.w * (c0[3] + c1[3]);
        }
        if (!last) {
#pragma unroll
            for (int j = 0; j < 4; ++j) *(f32x4*)(xr + 4 * lane + 256 * j) = v[j];
            f32x4 h[4];
            const float* m = MOD + ((size_t)(l + 1) * 3 + row_mv(r)) * 6144;
            norm_mod_row(v, a.in[I_N1G] + (l + 1) * D, m, m + 1024, H + (size_t)r * D, lane, h);
        } else {
            float s = 0.f;
#pragma unroll
            for (int j = 0; j < 4; ++j) s += (v[j].x * v[j].x + v[j].y * v[j].y) + (v[j].z * v[j].z + v[j].w * v[j].w);
            s = wave_sum_shfl(s);
            const float rstd = rsqrtf(s * (1.0f / D) + NORM_EPS);
#pragma unroll
            for (int j = 0; j < 4; ++j) {
                const int idx = 4 * lane + 256 * j;
                const f32x4 g = *(const f32x4*)(a.in[I_FG] + idx);
                f32x4 o; o.x = v[j].x * rstd * g.x; o.y = v[j].y * rstd * g.y; o.z = v[j].z * rstd * g.z; o.w = v[j].w * rstd * g.w;
                *(f32x4*)(xr + idx) = o;
            }
        }
    }
}

__global__ void __launch_bounds__(512) mega(Args a_in) {
    extern __shared__ __attribute__((aligned(16))) unsigned char lds_raw[];
    LAS unsigned char* lds = (LAS unsigned char*)lds_raw;
    volatile LAS unsigned* misc = (volatile LAS unsigned*)(lds + LDS_MISC);
    if (threadIdx.x < 64) misc[threadIdx.x] = 0u;
    __syncthreads();
    const bool multi = (a_in.ph_hi - a_in.ph_lo) > 1;
    XcdBarrier bar; bar.bar = (unsigned*)(a_in.ws + WS_CTL) + CW_BAR; bar.x = 0; bar.st = misc;
    if (multi) bar = xcd_barrier_post((unsigned*)(a_in.ws + WS_CTL) + CW_BAR, misc);

    const Args& a0 = a_in;
    for (int ph = a0.ph_lo; ph < a0.ph_hi; ++ph) {
        Args a = a0;
        { unsigned long long w_ = (unsigned long long)a.ws; asm volatile("" : "+s"(w_)); a.ws = (unsigned char*)w_; }
        { unsigned long long w_ = (unsigned long long)a.out; asm volatile("" : "+s"(w_)); a.out = (float*)w_; }
        int tid = threadIdx.x; asm volatile("" : "+v"(tid));
        const int lane = tid & 63, wave = __builtin_amdgcn_readfirstlane(tid >> 6);
        const int gw = blockIdx.x * 8 + wave, nw = gridDim.x * 8;
        if (ph == 0 && SUB_ON(100)) {
            phase_mod(a, lds, tid, lane, wave);
            for (int it = gw; it < CONV_CORE_ITEMS; it += nw) conv_core(a, 0, it, lane);
        } else if (ph == 1 && SUB_ON(101)) {
            phase_norm1(a, 0, lane, gw, nw);
        } else if (ph >= 2) {
            const int l = (ph - 2) / 13, sub = (ph - 2) % 13;
            const bool last = (l == 1), need_ctx = !last;
            switch (sub) {
            case 0: if (!SUB_ON(0)) break; phase_inproj(a, lds, tid, lane, wave); break;
            case 1: if (!SUB_ON(1)) break; phase_ml_a(a, l, lds, tid, lane, wave); break;
            case 2: if (!SUB_ON(2)) break; phase_ml_b(a, tid); break;
            case 3: if (!SUB_ON(3)) break; phase_ml_c(a, l, need_ctx, lds, tid, lane, wave); break;
            case 4: if (!SUB_ON(4)) break; phase_rw_prep(a, l, lane, gw, nw); break;
            case 5: if (!SUB_ON(5)) break; phase_rw_scan(a, lds, tid, lane, wave); break;
            case 6: if (!SUB_ON(6)) break; phase_rw_out(a, l, need_ctx, lane, gw, nw); break;
            case 7: if (!SUB_ON(7)) break; phase_merge1(a, need_ctx, lds, tid, lane, wave);
                    for (int it = gw; it < CONV_EXP_ITEMS; it += nw) conv_exp(a, l, it, lane);
                    break;
            case 8: if (!SUB_ON(8)) break; phase_merge2(a, l, need_ctx, lds, tid, lane, wave); break;
            case 9: if (!SUB_ON(9)) break; phase_router(a, l, need_ctx, lds, tid, lane, gw, nw); break;
            case 10: if (!SUB_ON(10)) break; phase_moe_up(a, l, lds, tid, lane, wave); break;
            case 11: if (!SUB_ON(11)) break; phase_moe_down(a, l, lds, tid, lane, wave); break;
            default: if (!SUB_ON(12)) break; phase_combine(a, l, need_ctx, last, lane, gw, nw);
                     if (!last) for (int it = gw; it < CONV_CORE_ITEMS; it += nw) conv_core(a, l + 1, it, lane);
                     break;
            }
        }
        if (ph + 1 < a0.ph_hi) xcd_barrier(bar);
    }
}
}

extern "C" void kernel_launch(void* const* d_in, const int* in_sizes, int n_in, void* d_out, int out_size, void* d_ws, size_t ws_size, hipStream_t stream) {
    static int grid = 0;
    if (grid == 0) {
        if (n_in != 33 || in_sizes[0] != RLAT * D || out_size != RLAT * D || ws_size < WS_NEED) {
            fprintf(stderr, "kernel_launch: unexpected shapes / workspace: n_in %d in0 %d out %d ws %zu (need %zu)\n", n_in, n_in > 0 ? in_sizes[0] : -1, out_size, ws_size, (size_t)WS_NEED);
            grid = -1; return;
        }
        int dev = 0, cus = 0;
        if (hipGetDevice(&dev) != hipSuccess || hipDeviceGetAttribute(&cus, hipDeviceAttributeMultiprocessorCount, dev) != hipSuccess) { grid = -1; return; }
        if (hipFuncSetAttribute((const void*)mega, hipFuncAttributeMaxDynamicSharedMemorySize, LDS_BYTES) != hipSuccess) { fprintf(stderr, "kernel_launch: hipFuncSetAttribute failed\n"); grid = -1; return; }
        (void)hipGetLastError();
        grid = cus;
    }
    if (grid < 0) return;
    (void)hipMemsetAsync((char*)d_ws + WS_CTL, 0, CTL_BYTES, stream);
    Args a{};
    for (int i = 0; i < 33; ++i) a.in[i] = (const float*)d_in[i];
    a.out = (float*)d_out; a.ws = (unsigned char*)d_ws;
#if MK_PER_PHASE
    for (int ph = 0; ph < NPHASE; ++ph) { a.ph_lo = ph; a.ph_hi = ph + 1; hipLaunchKernelGGL(mega, dim3(grid), dim3(512), LDS_BYTES, stream, a); }
#else
    a.ph_lo = 0; a.ph_hi = NPHASE;
    hipLaunchKernelGGL(mega, dim3(grid), dim3(512), LDS_BYTES, stream, a);
#endif
}
```

```cpp
#include <hip/hip_runtime.h>
#include <cstdio>
#include <cstdint>

#ifndef MK_PER_PHASE
#define MK_PER_PHASE 0
#endif

#ifndef ONLY_SUB
#define ONLY_SUB -1
#endif
#define SUB_ON(k) (ONLY_SUB < 0 || ONLY_SUB == (k))
#ifndef PROBE_SUB
#define PROBE_SUB -1
#endif
#define REP(k) for (int rep_ = 0; rep_ < ((PROBE_SUB == (k)) ? 2 : 1); ++rep_)
#define LAS __attribute__((address_space(3)))
typedef unsigned short bf16_t;
typedef short bf16x8 __attribute__((ext_vector_type(8)));
typedef float f32x4 __attribute__((ext_vector_type(4)));
typedef unsigned u32x4 __attribute__((ext_vector_type(4)));
typedef unsigned u32x2 __attribute__((ext_vector_type(2)));

namespace {
constexpr int D = 1024, NBATCH = 2, TL = 8192, TC = 256;
constexpr int RLAT = NBATCH * TL, RCTX = NBATCH * TC, RT = RLAT + RCTX;
constexpr int ML_H = 4, ML_COLS = 1552;
constexpr int RW_H = 8, RW_W = 512, RW_COLS = 1920, GT_COLS = 2048, IN_COLS = 5520, IN_PAD = 5632;
constexpr int NE = 16, DE = 512;
constexpr int NCH = 132;
constexpr int SEQ = TC + TL;
constexpr float NORM_EPS = 1e-6f, GATE_CAP = 15.0f, RW_GN_EPS = 6.4e-4f;
constexpr int NPHASE = 28;

constexpr size_t WS_CTL = 0;
constexpr size_t CTL_BYTES = 65536;
constexpr size_t CW_BAR = 0;
constexpr size_t CW_CNT = 4096;
constexpr size_t WS_MOD = WS_CTL + CTL_BYTES;
constexpr size_t WS_XCTX = WS_MOD + 163840;
constexpr size_t WS_WIN = WS_XCTX + (size_t)RCTX * D * 4;
constexpr size_t WS_WPA = WS_WIN + (size_t)IN_PAD * D * 2;
constexpr size_t WS_WPB = WS_WPA + (size_t)D * 512 * 2;
constexpr size_t WS_WOUT = WS_WPB + (size_t)D * 512 * 2;
constexpr size_t WS_WUP = WS_WOUT + (size_t)D * D * 2;
constexpr size_t WS_AUP = WS_WUP + 2 * 512 * 64 * 2;
constexpr size_t WS_GUP = WS_AUP + 2 * 512 * 64 * 2;
constexpr size_t WS_ARENA = WS_GUP + 512 * 128 * 2;
constexpr size_t SZ_PGT = (size_t)RT * GT_COLS * 2, SZ_PRW = (size_t)RT * RW_COLS * 2, SZ_PML = (size_t)RT * ML_COLS * 2;
constexpr size_t SZ_R1K = (size_t)RT * D * 2;
constexpr size_t SZ_R512 = (size_t)RT * 512 * 2;
constexpr size_t A_PGT = WS_ARENA;
constexpr size_t A_PRW = A_PGT + SZ_PGT;
constexpr size_t A_PML = A_PRW + SZ_PRW;
constexpr size_t A_H = A_PML + SZ_PML;
constexpr size_t A_DC = A_H;
constexpr size_t A_DN = A_DC + (size_t)16 * NCH * 8192 * 4;
constexpr size_t A_G = A_DN + (size_t)16 * NCH * 64 * 4;
constexpr size_t A_ALAT = A_G + (size_t)16 * NCH * 4;
constexpr size_t A_SR = A_ALAT + SZ_R512;
constexpr size_t A_SV = A_SR + SZ_R512;
constexpr size_t A_SG = A_SV + SZ_R512;
constexpr size_t A_BONUS = A_SG + SZ_R512;
constexpr size_t A_BLAT = A_BONUS + (size_t)RT * 8 * 4;
constexpr size_t A_END = A_BLAT + SZ_R512;
constexpr size_t A_SOMW0 = A_PML;
constexpr size_t A_SOMW1 = A_SOMW0 + SZ_R512, A_SKKA0 = A_SOMW1 + SZ_R512, A_SKKA1 = A_SKKA0 + SZ_R512;
constexpr size_t A_SKD0 = A_SKKA1 + SZ_R512, A_SKD1 = A_SKD0 + SZ_R512, A_SKK = A_SKD1 + SZ_R512;
static_assert(A_SKK + SZ_R512 <= A_DN, "stream overlay");
constexpr size_t A_Y = A_PRW;
static_assert((size_t)2 * 16 * 64 * SEQ * 2 <= SZ_PRW, "Y overlay");
constexpr size_t A_U = A_PML;
constexpr size_t A_H2 = A_U + SZ_R1K;
constexpr size_t A_WG = A_H2 + SZ_R1K;
constexpr size_t A_WU = A_WG + (size_t)NE * DE * D * 2;
constexpr size_t A_WD = A_WU + (size_t)NE * DE * D * 2;
static_assert(A_WD + (size_t)NE * DE * D * 2 <= A_ALAT, "expert weight overlay");
constexpr size_t A_LIST = A_ALAT;
constexpr size_t A_TOKW = A_LIST + (size_t)NE * RT * 4;
static_assert(A_TOKW + (size_t)RT * 8 <= A_SR, "list overlay");
constexpr size_t A_HID = A_PGT;
constexpr size_t A_CONTRIB = A_HID + (size_t)2 * RT * DE * 2;
static_assert(A_CONTRIB + (size_t)2 * RT * D * 2 <= A_PML, "contrib overlay");
constexpr size_t WS_NEED = A_END;

constexpr int LDS_BYTES = 147456;
constexpr int LDS_MISC = 147456 - 256;

__device__ __forceinline__ float bf2f(unsigned h) { return __uint_as_float(h << 16); }
__device__ __forceinline__ unsigned f2bf(float f) { unsigned u = __float_as_uint(f); return (u + 0x7fffu + ((u >> 16) & 1u)) >> 16; }
__device__ __forceinline__ unsigned pk2(float lo, float hi) { return f2bf(lo) | (f2bf(hi) << 16); }
__device__ __forceinline__ float sigmoidf_(float x) { return 1.0f / (1.0f + __expf(-x)); }
__device__ __forceinline__ float siluf_(float x) { return x / (1.0f + __expf(-x)); }
__device__ __forceinline__ float tanhf_(float x) { return 1.0f - 2.0f / (__expf(2.0f * x) + 1.0f); }
__device__ __forceinline__ float softplusf_(float x) { return fmaxf(x, 0.f) + __logf(1.0f + __expf(-fabsf(x))); }
__device__ __forceinline__ float wave_sum_shfl(float v) {
#pragma unroll
    for (int o = 1; o < 64; o <<= 1) v += __shfl_xor(v, o);
    return v;
}
template <int CTRL> __device__ __forceinline__ float dpp_mov(float v) {
    return __int_as_float(__builtin_amdgcn_update_dpp(0, __float_as_int(v), CTRL, 0xf, 0xf, true));
}
__device__ __forceinline__ float wave_sum_dpp(float v) {
    v += dpp_mov<0xB1>(v);
    v += dpp_mov<0x4E>(v);
    v += dpp_mov<0x141>(v);
    v += dpp_mov<0x140>(v);
    { auto r = __builtin_amdgcn_permlane16_swap(__float_as_uint(v), __float_as_uint(v), false, false); unsigned a = r[0], b = r[1]; v = __uint_as_float(a) + __uint_as_float(b); }
    { auto r = __builtin_amdgcn_permlane32_swap(__float_as_uint(v), __float_as_uint(v), false, false); unsigned a = r[0], b = r[1]; v = __uint_as_float(a) + __uint_as_float(b); }
    return v;
}
__device__ __forceinline__ void unpack8(u32x4 w, float (&o)[8]) {
    o[0] = bf2f(w.x & 0xffffu); o[1] = __uint_as_float(w.x & 0xffff0000u); o[2] = bf2f(w.y & 0xffffu); o[3] = __uint_as_float(w.y & 0xffff0000u);
    o[4] = bf2f(w.z & 0xffffu); o[5] = __uint_as_float(w.z & 0xffff0000u); o[6] = bf2f(w.w & 0xffffu); o[7] = __uint_as_float(w.w & 0xffff0000u);
}
__device__ __forceinline__ void unpack4(u32x2 w, float (&o)[4]) {
    o[0] = bf2f(w.x & 0xffffu); o[1] = __uint_as_float(w.x & 0xffff0000u); o[2] = bf2f(w.y & 0xffffu); o[3] = __uint_as_float(w.y & 0xffff0000u);
}

#define XB_TMO      128
#define XB_XCNT(j)  (256  + 64 * (j))
#define XB_XSUB(j)  (1280 + 64 * (j))
#define XB_XGEN(j)  (2304 + 64 * (j))
#define XB_TOP      3328
#define XB_TOPGEN   3392
#define XCD_BAR_WORDS 3456
#define XB_SPIN_CAP (1u << 24)
__device__ __forceinline__ unsigned xb_ld(unsigned* p)              { return __hip_atomic_load(p, __ATOMIC_RELAXED, __HIP_MEMORY_SCOPE_AGENT); }
__device__ __forceinline__ unsigned xb_add(unsigned* p, unsigned v) { return __hip_atomic_fetch_add(p, v, __ATOMIC_RELAXED, __HIP_MEMORY_SCOPE_AGENT); }
__device__ __forceinline__ unsigned xb_xcc_id() { return (unsigned)__builtin_amdgcn_s_getreg((3 << 11) | 20) & 0xFu; }
#define XB_SPIN(cond, bar) do { unsigned _sp = 0; while (cond) { __builtin_amdgcn_s_sleep(1); \
    if ((++_sp & 255u) == 0u) { if (xb_ld(&(bar)[XB_TMO])) break; if (_sp > XB_SPIN_CAP) { atomicAdd(&(bar)[XB_TMO], 1u); break; } } } } while (0)
struct XcdBarrier { unsigned* bar; unsigned x; volatile LAS unsigned* st; };
__device__ __forceinline__ XcdBarrier xcd_barrier_post(unsigned* bar, volatile LAS unsigned* st) {
    XcdBarrier b; b.bar = bar; b.x = xb_xcc_id(); b.st = st;
    if (threadIdx.x == 0) (void)xb_add(&bar[XB_XCNT(b.x)], 1u);
    return b;
}
__device__ __forceinline__ void xcd_barrier_complete(unsigned* bar, unsigned x, unsigned& nloc, unsigned& nx) {
    const unsigned G = gridDim.x * gridDim.y * gridDim.z;
    unsigned sum, cnt, mine, sp = 0u;
    for (;;) {
        sum = 0u; cnt = 0u; mine = 0u;
#pragma unroll
        for (unsigned j = 0; j < 16; ++j) { const unsigned c = xb_ld(&bar[XB_XCNT(j)]); sum += c; cnt += (c > 0u) ? 1u : 0u; mine = (j == x) ? c : mine; }
        if (sum == G) break;
        __builtin_amdgcn_s_sleep(1);
        if ((++sp & 255u) == 0u) { if (xb_ld(&bar[XB_TMO])) break; if (sp > XB_SPIN_CAP) { atomicAdd(&bar[XB_TMO], 1u); break; } }
    }
    nloc = mine > 0u ? mine : 1u; nx = cnt > 0u ? cnt : 1u;
}
__device__ __forceinline__ void xcd_barrier(const XcdBarrier& b) {
    asm volatile("s_waitcnt vmcnt(0)" ::: "memory");
    __syncthreads();
    if (threadIdx.x == 0) {
        unsigned* bar = b.bar;
        __builtin_amdgcn_s_waitcnt(0);
        unsigned nloc = b.st[0], nx = b.st[1];
        if (nloc == 0u) { xcd_barrier_complete(bar, b.x, nloc, nx); b.st[0] = nloc; b.st[1] = nx; }
        const unsigned old = xb_add(&bar[XB_XSUB(b.x)], 1u);
        const unsigned gen = old / nloc;
        if (old + 1u == (gen + 1u) * nloc) {
            __builtin_amdgcn_fence(__ATOMIC_RELEASE, "agent");
            asm volatile("s_waitcnt vmcnt(0)" ::: "memory");
            const unsigned og = xb_add(&bar[XB_TOP], 1u);
            const unsigned tg = og / nx;
            if (og + 1u == (tg + 1u) * nx) xb_add(&bar[XB_TOPGEN], 1u);
            else XB_SPIN(xb_ld(&bar[XB_TOPGEN]) == tg, bar);
            __builtin_amdgcn_fence(__ATOMIC_ACQUIRE, "agent");
            xb_add(&bar[XB_XGEN(b.x)], 1u);
            asm volatile("s_waitcnt vmcnt(0)" ::: "memory");
        } else {
            XB_SPIN(xb_ld(&bar[XB_XGEN(b.x)]) == gen, bar);
            __builtin_amdgcn_fence(__ATOMIC_ACQUIRE, "agent");
            asm volatile("s_waitcnt vmcnt(0)" ::: "memory");
        }
    }
    __syncthreads();
}

struct Args { const float* in[33]; float* out; unsigned char* ws; int ph_lo, ph_hi; };
enum { I_X = 0, I_C, I_CTX, I_CCTX, I_WADA, I_BADA, I_N1G, I_N2G, I_WIN, I_CONVK, I_CONVB, I_GATEB, I_MLNG, I_MU, I_WUP, I_W0, I_AUP, I_A0, I_GUP, I_KK, I_KA, I_RK,
       I_LNW, I_LNB, I_PA, I_PB, I_WOUT, I_RTW, I_RTB, I_EG, I_EU, I_ED, I_FG };

__device__ __forceinline__ int row_mv(int r) { return r < RLAT ? (r >> 13) : 2; }

__device__ __forceinline__ void conv_item(const float* __restrict__ W, int K, int N, bf16_t* __restrict__ WT, int item, int lane) {
    const int nkb = K >> 6;
    const int nb = item / nkb, kb = item - nb * nkb;
    const int n = nb * 64 + lane, k0 = kb * 64;
    float v[64];
    if (n < N) {
        const float* p = W + (size_t)k0 * N + n;
#pragma unroll
        for (int i = 0; i < 64; ++i) v[i] = p[(size_t)i * N];
    } else {
#pragma unroll
        for (int i = 0; i < 64; ++i) v[i] = 0.f;
    }
    u32x4* o = (u32x4*)(WT + (size_t)n * K + k0);
#pragma unroll
    for (int i = 0; i < 8; ++i) { u32x4 w; w.x = pk2(v[8 * i], v[8 * i + 1]); w.y = pk2(v[8 * i + 2], v[8 * i + 3]); w.z = pk2(v[8 * i + 4], v[8 * i + 5]); w.w = pk2(v[8 * i + 6], v[8 * i + 7]); o[i] = w; }
}
constexpr int CONV_CORE_ITEMS = 1408 + 128 + 128 + 256 + 16 + 16 + 16;
__device__ __forceinline__ void conv_core(const Args& a, int l, int item, int lane) {
    unsigned char* ws = a.ws;
    if (item < 1408) { conv_item(a.in[I_WIN] + (size_t)l * D * IN_COLS, D, IN_COLS, (bf16_t*)(ws + WS_WIN), item, lane); return; } item -= 1408;
    if (item < 128) { conv_item(a.in[I_PA] + (size_t)l * 512 * D, 512, D, (bf16_t*)(ws + WS_WPA), item, lane); return; } item -= 128;
    if (item < 128) { conv_item(a.in[I_PB] + (size_t)l * 512 * D, 512, D, (bf16_t*)(ws + WS_WPB), item, lane); return; } item -= 128;
    if (item < 256) { conv_item(a.in[I_WOUT] + (size_t)l * D * D, D, D, (bf16_t*)(ws + WS_WOUT), item, lane); return; } item -= 256;
    if (item < 16) { const int d = item >> 3; conv_item(a.in[I_WUP] + (size_t)(l * 2 + d) * 64 * 512, 64, 512, (bf16_t*)(ws + WS_WUP) + d * 512 * 64, item & 7, lane); return; } item -= 16;
    if (item < 16) { const int d = item >> 3; conv_item(a.in[I_AUP] + (size_t)(l * 2 + d) * 64 * 512, 64, 512, (bf16_t*)(ws + WS_AUP) + d * 512 * 64, item & 7, lane); return; } item -= 16;
    conv_item(a.in[I_GUP] + (size_t)l * 128 * 512, 128, 512, (bf16_t*)(ws + WS_GUP), item, lane);
}
constexpr int CONV_EXP_ITEMS = 3 * 2048;
__device__ __forceinline__ void conv_exp(const Args& a, int l, int item, int lane) {
    unsigned char* ws = a.ws;
    const int which = item >> 11, it = item & 2047, e = it >> 7, sub = it & 127;
    if (which == 0) conv_item(a.in[I_EG] + ((size_t)l * NE + e) * D * DE, D, DE, (bf16_t*)(ws + A_WG) + (size_t)e * DE * D, sub, lane);
    else if (which == 1) conv_item(a.in[I_EU] + ((size_t)l * NE + e) * D * DE, D, DE, (bf16_t*)(ws + A_WU) + (size_t)e * DE * D, sub, lane);
    else conv_item(a.in[I_ED] + ((size_t)l * NE + e) * DE * D, DE, D, (bf16_t*)(ws + A_WD) + (size_t)e * D * DE, sub, lane);
}

__device__ __forceinline__ void phase_mod(const Args& a, LAS unsigned char* lds, int tid, int lane, int wave) {
    LAS float* sv = (LAS float*)lds;
    LAS float* part = sv + 3 * 1024;
    for (int i = tid; i < 3 * 1024; i += 512) {
        const int v = i >> 10, k = i & 1023;
        const float c = (v < 2) ? a.in[I_C][v * 1024 + k] : a.in[I_CCTX][k];
        sv[i] = siluf_(c);
    }
    __syncthreads();
    float* MOD = (float*)(a.ws + WS_MOD);
    for (int cb = blockIdx.x; cb < 256; cb += gridDim.x) {
        const int gc0 = cb * 48, l = gc0 / 6144, n0 = gc0 % 6144;
        float acc0 = 0.f, acc1 = 0.f, acc2 = 0.f;
        if (lane < 48) {
            const float* w = a.in[I_WADA] + (size_t)l * D * 6144 + n0 + lane;
            const int k0 = wave * 128;
#pragma unroll 8
            for (int k = 0; k < 128; ++k) { const float wv = w[(size_t)(k0 + k) * 6144]; acc0 += sv[k0 + k] * wv; acc1 += sv[1024 + k0 + k] * wv; acc2 += sv[2048 + k0 + k] * wv; }
            part[(wave * 3 + 0) * 48 + lane] = acc0; part[(wave * 3 + 1) * 48 + lane] = acc1; part[(wave * 3 + 2) * 48 + lane] = acc2;
        }
        __syncthreads();
        if (tid < 144) {
            const int v = tid / 48, j = tid % 48;
            float s = a.in[I_BADA][l * 6144 + n0 + j];
#pragma unroll
            for (int w8 = 0; w8 < 8; ++w8) s += part[(w8 * 3 + v) * 48 + j];
            MOD[((size_t)l * 3 + v) * 6144 + n0 + j] = s;
        }
        __syncthreads();
    }
}

__device__ __forceinline__ const float* xrow_in(const Args& a, int l, int r) {
    if (r < RLAT) return (l == 0 ? a.in[I_X] : (const float*)a.out) + (size_t)r * D;
    return (l == 0 ? a.in[I_CTX] : (const float*)(a.ws + WS_XCTX)) + (size_t)(r - RLAT) * D;
}
__device__ __forceinline__ float* xrow_out(const Args& a, int r) {
    if (r < RLAT) return a.out + (size_t)r * D;
    return (float*)(a.ws + WS_XCTX) + (size_t)(r - RLAT) * D;
}
__device__ __forceinline__ void norm_mod_row(const f32x4 (&v)[4], const float* __restrict__ g, const float* __restrict__ sh, const float* __restrict__ sc, bf16_t* __restrict__ orow, int lane, f32x4 (&hout)[4]) {
    float s = 0.f;
#pragma unroll
    for (int j = 0; j < 4; ++j) s += (v[j].x * v[j].x + v[j].y * v[j].y) + (v[j].z * v[j].z + v[j].w * v[j].w);
    s = wave_sum_shfl(s);
    const float rstd = rsqrtf(s * (1.0f / D) + NORM_EPS);
#pragma unroll
    for (int j = 0; j < 4; ++j) {
        const int idx = 4 * lane + 256 * j;
        const f32x4 gg = *(const f32x4*)(g + idx), s1 = *(const f32x4*)(sc + idx), s0 = *(const f32x4*)(sh + idx);
        f32x4 h;
        h.x = v[j].x * rstd * gg.x * (1.f + s1.x) + s0.x; h.y = v[j].y * rstd * gg.y * (1.f + s1.y) + s0.y;
        h.z = v[j].z * rstd * gg.z * (1.f + s1.z) + s0.z; h.w = v[j].w * rstd * gg.w * (1.f + s1.w) + s0.w;
        hout[j] = h;
        u32x2 o; o.x = pk2(h.x, h.y); o.y = pk2(h.z, h.w);
        *(u32x2*)(orow + idx) = o;
    }
}
__device__ __forceinline__ void phase_norm1(const Args& a, int l, int lane, int gw, int nw) {
    const float* MOD = (const float*)(a.ws + WS_MOD);
    bf16_t* H = (bf16_t*)(a.ws + A_H);
    for (int r = gw; r < RT; r += nw) {
        const float* xr = xrow_in(a, l, r);
        f32x4 v[4], h[4];
#pragma unroll
        for (int j = 0; j < 4; ++j) v[j] = *(const f32x4*)(xr + 4 * lane + 256 * j);
        const float* m = MOD + ((size_t)l * 3 + row_mv(r)) * 6144;
        norm_mod_row(v, a.in[I_N1G] + l * D, m, m + 1024, H + (size_t)r * D, lane, h);
    }
}

constexpr int G_LD = 72;
constexpr int G_OPER = 128 * G_LD;
__device__ __forceinline__ void gemm_tile(LAS bf16_t* sm, const bf16_t* pa0, const bf16_t* pa1, const bf16_t* pb0, const bf16_t* pb1, int nk,
                                          f32x4 (&acc)[4][2], int tid, int lane, int wm, int wn) {
    const int srow = tid >> 3, skc = tid & 7;
    const int so0 = srow * G_LD + skc * 8, so1 = (srow + 64) * G_LD + skc * 8;
    const int fr = lane & 15, fq = lane >> 4;
    u32x4 ra0 = *(const u32x4*)pa0, ra1 = *(const u32x4*)pa1, rb0 = *(const u32x4*)pb0, rb1 = *(const u32x4*)pb1;
    *(LAS u32x4*)(sm + so0) = ra0; *(LAS u32x4*)(sm + so1) = ra1; *(LAS u32x4*)(sm + G_OPER + so0) = rb0; *(LAS u32x4*)(sm + G_OPER + so1) = rb1;
    __syncthreads();
    for (int ks = 0; ks < nk; ++ks) {
        LAS bf16_t* A = sm + (ks & 1) * 2 * G_OPER;
        LAS bf16_t* B = A + G_OPER;
        const bool more = (ks + 1 < nk);
        if (more) { const int ko = (ks + 1) * 64; ra0 = *(const u32x4*)(pa0 + ko); ra1 = *(const u32x4*)(pa1 + ko); rb0 = *(const u32x4*)(pb0 + ko); rb1 = *(const u32x4*)(pb1 + ko); }
#pragma unroll
        for (int kk = 0; kk < 2; ++kk) {
            bf16x8 af[4], bfr[2];
#pragma unroll
            for (int mi = 0; mi < 4; ++mi) af[mi] = *(const LAS bf16x8*)(A + (wm * 64 + mi * 16 + fr) * G_LD + kk * 32 + fq * 8);
#pragma unroll
            for (int ni = 0; ni < 2; ++ni) bfr[ni] = *(const LAS bf16x8*)(B + (wn * 32 + ni * 16 + fr) * G_LD + kk * 32 + fq * 8);
#pragma unroll
            for (int mi = 0; mi < 4; ++mi)
#pragma unroll
                for (int ni = 0; ni < 2; ++ni) acc[mi][ni] = __builtin_amdgcn_mfma_f32_16x16x32_bf16(bfr[ni], af[mi], acc[mi][ni], 0, 0, 0);
        }
        if (more) {
            LAS bf16_t* A2 = sm + ((ks + 1) & 1) * 2 * G_OPER;
            *(LAS u32x4*)(A2 + so0) = ra0; *(LAS u32x4*)(A2 + so1) = ra1; *(LAS u32x4*)(A2 + G_OPER + so0) = rb0; *(LAS u32x4*)(A2 + G_OPER + so1) = rb1;
        }
        __syncthreads();
    }
}
#define ZERO_ACC(acc) do { _Pragma("unroll") for (int _i = 0; _i < 4; ++_i) _Pragma("unroll") for (int _j = 0; _j < 2; ++_j) acc[_i][_j] = (f32x4){0.f, 0.f, 0.f, 0.f}; } while (0)

__device__ __forceinline__ void phase_inproj(const Args& a, LAS unsigned char* lds, int tid, int lane, int wave) {
    LAS bf16_t* sm = (LAS bf16_t*)lds;
    const bf16_t* H = (const bf16_t*)(a.ws + A_H);
    const bf16_t* WT = (const bf16_t*)(a.ws + WS_WIN);
    bf16_t* PML = (bf16_t*)(a.ws + A_PML); bf16_t* PRW = (bf16_t*)(a.ws + A_PRW); bf16_t* PGT = (bf16_t*)(a.ws + A_PGT);
    const int wm = wave >> 2, wn = wave & 3, fr = lane & 15, fq = lane >> 4;
    const int srow = tid >> 3, skc = tid & 7;
    constexpr int NM = RT / 128, NN = IN_PAD / 128;
    for (int tile = blockIdx.x; tile < NM * NN; tile += gridDim.x) {
        const int tm = tile / NN, tn = tile - tm * NN;
        const bf16_t* pa0 = H + (size_t)(tm * 128 + srow) * D + skc * 8;
        const bf16_t* pa1 = pa0 + (size_t)64 * D;
        const bf16_t* pb0 = WT + (size_t)(tn * 128 + srow) * D + skc * 8;
        const bf16_t* pb1 = pb0 + (size_t)64 * D;
        f32x4 acc[4][2]; ZERO_ACC(acc);
        gemm_tile(sm, pa0, pa1, pb0, pb1, D / 64, acc, tid, lane, wm, wn);
#pragma unroll
        for (int mi = 0; mi < 4; ++mi) {
            const int row = tm * 128 + wm * 64 + mi * 16 + fr;
#pragma unroll
            for (int ni = 0; ni < 2; ++ni) {
                const int nc = tn * 128 + wn * 32 + ni * 16 + 4 * fq;
                u32x2 o; o.x = pk2(acc[mi][ni][0], acc[mi][ni][1]); o.y = pk2(acc[mi][ni][2], acc[mi][ni][3]);
                if (nc < ML_COLS) *(u32x2*)(PML + (size_t)row * ML_COLS + nc) = o;
                else if (nc < ML_COLS + RW_COLS) *(u32x2*)(PRW + (size_t)row * RW_COLS + (nc - ML_COLS)) = o;
                else if (nc < IN_COLS) *(u32x2*)(PGT + (size_t)row * GT_COLS + (nc - ML_COLS - RW_COLS)) = o;
            }
        }
    }
}

template <int KS> __device__ __forceinline__ f32x4 lds_mma(const LAS bf16_t* A, int lda, int m0, const LAS bf16_t* Bt, int ldb, int n0, f32x4 acc, int fr, int fq) {
#pragma unroll
    for (int ks = 0; ks < KS; ++ks) {
        const bf16x8 av = *(const LAS bf16x8*)(A + (m0 + fr) * lda + ks * 32 + fq * 8);
        const bf16x8 bv = *(const LAS bf16x8*)(Bt + (n0 + fr) * ldb + ks * 32 + fq * 8);
        acc = __builtin_amdgcn_mfma_f32_16x16x32_bf16(bv, av, acc, 0, 0, 0);
    }
    return acc;
}

__device__ __forceinline__ int chunk_row0(int b, int cc) { return cc < 4 ? RLAT + b * TC + cc * 64 : b * TL + (cc - 4) * 64; }
__device__ __forceinline__ void ml_gates(const Args& a, int l, int h, int row0, LAS float* gt, int lane) {
    const bf16_t* PML = (const bf16_t*)(a.ws + A_PML);
    const float* gb = a.in[I_GATEB] + l * 16;
    const bf16_t* p = PML + (size_t)(row0 + lane) * ML_COLS + 1536;
    float pre[4];
#pragma unroll
    for (int ty = 0; ty < 2; ++ty)
#pragma unroll
        for (int d = 0; d < 2; ++d) {
            const int ix = ty * 8 + d * 4 + h;
            const float x = bf2f(p[ix]) + gb[ix];
            pre[ty * 2 + d] = GATE_CAP * tanhf_(x * (1.0f / GATE_CAP));
        }
    float lff = -softplusf_(-pre[2]);
    float lfb = -softplusf_(-pre[3]);
    float cf = lff, cb = lfb;
#pragma unroll
    for (int o = 1; o < 64; o <<= 1) {
        const float uf = __shfl_up(cf, o), ub = __shfl_down(cb, o);
        if (lane >= o) cf += uf;
        if (lane + o < 64) cb += ub;
    }
    gt[lane] = cf; gt[64 + lane] = pre[0]; gt[128 + lane] = cb; gt[192 + lane] = pre[1];
}
__device__ __forceinline__ void ml_conv8(const Args& a, int l, int b, int cc, int t, int col, float (&o)[8]) {
    const bf16_t* PML = (const bf16_t*)(a.ws + A_PML);
    const float* taps = a.in[I_CONVK] + (size_t)l * 9 * 512;
    const float* bias = a.in[I_CONVB] + l * 512;
    { const f32x4 b0 = *(const f32x4*)(bias + col), b1 = *(const f32x4*)(bias + col + 4); o[0] = b0.x; o[1] = b0.y; o[2] = b0.z; o[3] = b0.w; o[4] = b1.x; o[5] = b1.y; o[6] = b1.z; o[7] = b1.w; }
#pragma unroll
    for (int dy = 0; dy < 3; ++dy)
#pragma unroll
        for (int dx = 0; dx < 3; ++dx) {
            int nr; bool ok;
            if (cc >= 4) { const int ny = (cc - 4) + dy - 1, nx = t + dx - 1; ok = (ny >= 0) && (ny < 128) && (nx >= 0) && (nx < 64); nr = b * TL + ny * 64 + nx; }
            else { const int nt = cc * 64 + t + dx - 1; ok = (dy == 1) && (nt >= 0) && (nt < TC); nr = RLAT + b * TC + nt; }
            if (ok) {
                float v[8]; unpack8(*(const u32x4*)(PML + (size_t)nr * ML_COLS + col), v);
                const float* tp = taps + (dy * 3 + dx) * 512 + col;
                const f32x4 t0 = *(const f32x4*)tp, t1 = *(const f32x4*)(tp + 4);
                o[0] += t0.x * v[0]; o[1] += t0.y * v[1]; o[2] += t0.z * v[2]; o[3] += t0.w * v[3];
                o[4] += t1.x * v[4]; o[5] += t1.y * v[5]; o[6] += t1.z * v[6]; o[7] += t1.w * v[7];
            }
        }
}
constexpr int ML_LD = 72;
__device__ __forceinline__ void ml_fill_vt(const Args& a, int h, int row0, LAS bf16_t* VT, int tid, int lane, int wave) {
    const bf16_t* PML = (const bf16_t*)(a.ws + A_PML);
#pragma unroll
    for (int i = 0; i < 2; ++i) {
        const int eg = wave * 2 + i;
        const u32x4 w = *(const u32x4*)(PML + (size_t)(row0 + lane) * ML_COLS + 512 + h * 128 + eg * 8);
        LAS bf16_t* d = VT + (eg * 8) * ML_LD + lane;
        d[0 * ML_LD] = (bf16_t)(w.x & 0xffffu); d[1 * ML_LD] = (bf16_t)(w.x >> 16); d[2 * ML_LD] = (bf16_t)(w.y & 0xffffu); d[3 * ML_LD] = (bf16_t)(w.y >> 16);
        d[4 * ML_LD] = (bf16_t)(w.z & 0xffffu); d[5 * ML_LD] = (bf16_t)(w.z >> 16); d[6 * ML_LD] = (bf16_t)(w.w & 0xffffu); d[7 * ML_LD] = (bf16_t)(w.w >> 16);
    }
    for (int i = tid; i < 16 * 64; i += 512) { const int rr = i >> 6, s = i & 63; VT[(128 + rr) * ML_LD + s] = (rr == 0) ? (bf16_t)0x3F80 : (bf16_t)0; }
}

__device__ __forceinline__ void phase_ml_a(const Args& a, int l, LAS unsigned char* lds, int tid, int lane, int wave) {
    LAS bf16_t* KTF = (LAS bf16_t*)lds;
    LAS bf16_t* KTB = KTF + 64 * ML_LD;
    LAS bf16_t* VT = KTB + 64 * ML_LD;
    LAS float* gt = (LAS float*)(VT + 144 * ML_LD);
    float* DC = (float*)(a.ws + A_DC); float* DN = (float*)(a.ws + A_DN); float* GG = (float*)(a.ws + A_G);
    const int fr = lane & 15, fq = lane >> 4;
    for (int item = blockIdx.x; item < NBATCH * ML_H * NCH; item += gridDim.x) {
        const int b = item / (ML_H * NCH), rem = item % (ML_H * NCH), h = rem / NCH, cc = rem % NCH;
        const int row0 = chunk_row0(b, cc);
        if (wave == 0) {
            ml_gates(a, l, h, row0, gt, lane);
            const float cf = gt[lane], cb = gt[128 + lane];
            const float cfl = __shfl(cf, 63), cb0 = __shfl(cb, 0);
            gt[256 + lane] = __expf(cfl - cf + gt[64 + lane]);
            gt[320 + lane] = __expf(cb0 - cb + gt[192 + lane]);
            if (lane == 0) {
                GG[((b * ML_H + h) * 2 + 0) * NCH + cc] = __expf(cfl);
                GG[((b * ML_H + h) * 2 + 1) * NCH + cc] = __expf(cb0);
            }
        }
        ml_fill_vt(a, h, row0, VT, tid, lane, wave);
        float kc[8];
        ml_conv8(a, l, b, cc, lane, 256 + h * 64 + wave * 8, kc);
        __syncthreads();
        {
            const float wf = gt[256 + lane] * 0.125f, wb = gt[320 + lane] * 0.125f;
#pragma unroll
            for (int j = 0; j < 8; ++j) { KTF[(wave * 8 + j) * ML_LD + lane] = (bf16_t)f2bf(kc[j] * wf); KTB[(wave * 8 + j) * ML_LD + lane] = (bf16_t)f2bf(kc[j] * wb); }
        }
        __syncthreads();
        for (int idx = wave; idx < 72; idx += 8) {
            const int dir = idx / 36, r2 = idx % 36, dt = r2 / 9, et = r2 % 9;
            f32x4 acc = {0.f, 0.f, 0.f, 0.f};
            acc = lds_mma<2>(dir ? KTB : KTF, ML_LD, dt * 16, VT, ML_LD, et * 16, acc, fr, fq);
            const size_t ci = (size_t)((b * ML_H + h) * 2 + dir) * NCH + cc;
            const int d = dt * 16 + fr;
            if (et < 8) *(f32x4*)(DC + ci * 8192 + d * 128 + et * 16 + 4 * fq) = acc;
            else if (fq == 0) DN[ci * 64 + d] = acc[0];
        }
        __syncthreads();
    }
}
__device__ __forceinline__ int ml_seq_cc(int dir, int i) { return dir ? (i < 4 ? 3 - i : 135 - i) : i; }
__device__ __forceinline__ void phase_ml_b(const Args& a, int tid) {
    float* DC = (float*)(a.ws + A_DC); float* DN = (float*)(a.ws + A_DN); const float* GG = (const float*)(a.ws + A_G);
    const int nthreads = gridDim.x * 512;
    for (int e = blockIdx.x * 512 + tid; e < 16 * 8192 + 16 * 64; e += nthreads) {
        int chain, elem, stride; float* base;
        if (e < 16 * 8192) { chain = e >> 13; elem = e & 8191; stride = 8192; base = DC + (size_t)chain * NCH * 8192 + elem; }
        else { const int e2 = e - 16 * 8192; chain = e2 >> 6; elem = e2 & 63; stride = 64; base = DN + (size_t)chain * NCH * 64 + elem; }
        const int dir = chain & 1;
        const float* g = GG + chain * NCH;
        float C = 0.f;
        for (int i0 = 0; i0 < NCH; i0 += 12) {
            float tv[12], gv[12];
#pragma unroll
            for (int j = 0; j < 12; ++j) { const int cc = ml_seq_cc(dir, i0 + j); tv[j] = base[(size_t)cc * stride]; gv[j] = g[cc]; }
#pragma unroll
            for (int j = 0; j < 12; ++j) { const int cc = ml_seq_cc(dir, i0 + j); base[(size_t)cc * stride] = C; C = gv[j] * C + tv[j]; }
        }
    }
}
__device__ __forceinline__ void phase_ml_c(const Args& a, int l, bool need_ctx, LAS unsigned char* lds, int tid, int lane, int wave) {
    LAS bf16_t* Q = (LAS bf16_t*)lds;
    LAS bf16_t* K = Q + 64 * ML_LD;
    LAS bf16_t* QF = K + 64 * ML_LD;
    LAS bf16_t* QB = QF + 64 * ML_LD;
    LAS bf16_t* SF = QB + 64 * ML_LD;
    LAS bf16_t* SB = SF + 64 * ML_LD;
    LAS bf16_t* VT = SB + 64 * ML_LD;
    LAS bf16_t* CF = VT + 144 * ML_LD;
    LAS bf16_t* CB = CF + 144 * ML_LD;
    LAS float* gt = (LAS float*)(CB + 144 * ML_LD);
    LAS float* red = gt + 256;
    const float* DC = (const float*)(a.ws + A_DC); const float* DN = (const float*)(a.ws + A_DN);
    const bf16_t* PML = (const bf16_t*)(a.ws + A_PML);
    bf16_t* AL = (bf16_t*)(a.ws + A_ALAT);
    const float* ng = a.in[I_MLNG] + l * 512;
    const int fr = lane & 15, fq = lane >> 4;
    for (int item = blockIdx.x; item < NBATCH * ML_H * NCH; item += gridDim.x) {
        const int b = item / (ML_H * NCH), rem = item % (ML_H * NCH), h = rem / NCH, cc = rem % NCH;
        if (cc < 4 && !need_ctx) continue;
        const int row0 = chunk_row0(b, cc);
        if (wave == 0) ml_gates(a, l, h, row0, gt, lane);
#pragma unroll
        for (int i = 0; i < 2; ++i) {
            const int g = tid + 512 * i, t = g >> 4, cg = g & 15;
            const int col = (cg < 8) ? (h * 64 + cg * 8) : (256 + h * 64 + (cg - 8) * 8);
            float o[8]; ml_conv8(a, l, b, cc, t, col, o);
            const float sc = (cg < 8) ? 1.0f : 0.125f;
            u32x4 w; w.x = pk2(o[0] * sc, o[1] * sc); w.y = pk2(o[2] * sc, o[3] * sc); w.z = pk2(o[4] * sc, o[5] * sc); w.w = pk2(o[6] * sc, o[7] * sc);
            *(LAS u32x4*)(((cg < 8) ? Q : K) + t * ML_LD + (cg & 7) * 8) = w;
        }
        ml_fill_vt(a, h, row0, VT, tid, lane, wave);
#pragma unroll
        for (int dir = 0; dir < 2; ++dir) {
            const size_t ci = (size_t)((b * ML_H + h) * 2 + dir) * NCH + cc;
            LAS bf16_t* CT = dir ? CB : CF;
            const float* src = DC + ci * 8192 + lane * 128 + wave * 16;
#pragma unroll
            for (int q4 = 0; q4 < 4; ++q4) {
                const f32x4 v = *(const f32x4*)(src + q4 * 4);
                LAS bf16_t* d = CT + (wave * 16 + q4 * 4) * ML_LD + lane;
                d[0] = (bf16_t)f2bf(v.x); d[ML_LD] = (bf16_t)f2bf(v.y); d[2 * ML_LD] = (bf16_t)f2bf(v.z); d[3 * ML_LD] = (bf16_t)f2bf(v.w);
            }
            for (int i = tid; i < 16 * 64; i += 512) { const int rr = i >> 6, dd = i & 63; CT[(128 + rr) * ML_LD + dd] = (rr == 0) ? (bf16_t)f2bf(DN[ci * 64 + dd]) : (bf16_t)0; }
        }
        __syncthreads();
        {
            const int tt = wave >> 1;
#pragma unroll
            for (int i = 0; i < 2; ++i) {
                const int st = (wave & 1) * 2 + i;
                f32x4 acc = {0.f, 0.f, 0.f, 0.f};
                acc = lds_mma<2>(Q, ML_LD, tt * 16, K, ML_LD, st * 16, acc, fr, fq);
                const int t = tt * 16 + fr, s0 = st * 16 + 4 * fq;
                const float bft = gt[t], bbt = gt[128 + t];
                float sf[4], sb[4];
#pragma unroll
                for (int r = 0; r < 4; ++r) {
                    const int s = s0 + r;
                    sf[r] = (s <= t) ? acc[r] * __expf(bft - gt[s] + gt[64 + s]) : 0.f;
                    sb[r] = (s >= t) ? acc[r] * __expf(bbt - gt[128 + s] + gt[192 + s]) : 0.f;
                }
                u32x2 w; w.x = pk2(sf[0], sf[1]); w.y = pk2(sf[2], sf[3]); *(LAS u32x2*)(SF + t * ML_LD + s0) = w;
                w.x = pk2(sb[0], sb[1]); w.y = pk2(sb[2], sb[3]); *(LAS u32x2*)(SB + t * ML_LD + s0) = w;
            }
            const int t = tid >> 3, dg = tid & 7;
            float qv[8]; unpack8(*(const LAS u32x4*)(Q + t * ML_LD + dg * 8), qv);
            const float ef = __expf(gt[t]), eb = __expf(gt[128 + t]);
            u32x4 w; w.x = pk2(qv[0] * ef, qv[1] * ef); w.y = pk2(qv[2] * ef, qv[3] * ef); w.z = pk2(qv[4] * ef, qv[5] * ef); w.w = pk2(qv[6] * ef, qv[7] * ef);
            *(LAS u32x4*)(QF + t * ML_LD + dg * 8) = w;
            w.x = pk2(qv[0] * eb, qv[1] * eb); w.y = pk2(qv[2] * eb, qv[3] * eb); w.z = pk2(qv[4] * eb, qv[5] * eb); w.w = pk2(qv[6] * eb, qv[7] * eb);
            *(LAS u32x4*)(QB + t * ML_LD + dg * 8) = w;
        }
        __syncthreads();
        const int tt = wave >> 1, eh = wave & 1;
        float hs[4][4];
        {
            f32x4 af[5], ab[5];
#pragma unroll
            for (int i = 0; i < 5; ++i) {
                const int et = (i < 4) ? (eh * 4 + i) : 8;
                f32x4 z = {0.f, 0.f, 0.f, 0.f};
                af[i] = lds_mma<2>(QF, ML_LD, tt * 16, CF, ML_LD, et * 16, z, fr, fq);
                af[i] = lds_mma<2>(SF, ML_LD, tt * 16, VT, ML_LD, et * 16, af[i], fr, fq);
                ab[i] = lds_mma<2>(QB, ML_LD, tt * 16, CB, ML_LD, et * 16, z, fr, fq);
                ab[i] = lds_mma<2>(SB, ML_LD, tt * 16, VT, ML_LD, et * 16, ab[i], fr, fq);
            }
            const float denf = __shfl(af[4][0], fr), denb = __shfl(ab[4][0], fr);
            const float rf = 1.0f / fmaxf(fabsf(denf), 1.0f), rb = 1.0f / fmaxf(fabsf(denb), 1.0f);
            float ss = 0.f;
#pragma unroll
            for (int i = 0; i < 4; ++i)
#pragma unroll
                for (int r = 0; r < 4; ++r) { const float v = af[i][r] * rf + ab[i][r] * rb; hs[i][r] = v; ss += v * v; }
            ss += __shfl_xor(ss, 16); ss += __shfl_xor(ss, 32);
            if (fq == 0) red[(tt * 16 + fr) * 2 + eh] = ss;
        }
        __syncthreads();
        {
            const int t = tt * 16 + fr;
            const float tot = red[t * 2] + red[t * 2 + 1];
            const float rinv = rsqrtf(tot * (1.0f / 128.0f) + NORM_EPS);
            const int row = row0 + t;
#pragma unroll
            for (int i = 0; i < 4; ++i) {
                const int col = h * 128 + (eh * 4 + i) * 16 + 4 * fq;
                float ov[4]; unpack4(*(const u32x2*)(PML + (size_t)row * ML_COLS + 1024 + col), ov);
                const f32x4 g4 = *(const f32x4*)(ng + col);
                u32x2 w;
                w.x = pk2(hs[i][0] * rinv * g4.x * sigmoidf_(ov[0]), hs[i][1] * rinv * g4.y * sigmoidf_(ov[1]));
                w.y = pk2(hs[i][2] * rinv * g4.z * sigmoidf_(ov[2]), hs[i][3] * rinv * g4.w * sigmoidf_(ov[3]));
                *(u32x2*)(AL + (size_t)row * 512 + col) = w;
            }
        }
        __syncthreads();
    }
}

__device__ __forceinline__ void rw_seq_bounds(int r, bool& hasp, bool& hasn) {
    int t, len;
    if (r < RLAT) { t = r & (TL - 1); len = TL; } else { t = (r - RLAT) & (TC - 1); len = TC; }
    hasp = t > 0; hasn = t < len - 1;
}
__device__ __forceinline__ void rw_shift8(const bf16_t* __restrict__ PRW, const float* __restrict__ mu, int r, bool hasp, bool hasn, int col, float (&o)[8]) {
    const bf16_t* p = PRW + (size_t)r * RW_COLS + col;
    float c[8], pv[8], nv[8];
    const float wp = hasp ? 0.5f : 0.f, wn = hasn ? 0.5f : 0.f;
    unpack8(*(const u32x4*)p, c);
    unpack8(*(const u32x4*)(p - (hasp ? RW_COLS : 0)), pv);
    unpack8(*(const u32x4*)(p + (hasn ? RW_COLS : 0)), nv);
    const f32x4 m0 = *(const f32x4*)(mu + col), m1 = *(const f32x4*)(mu + col + 4);
    const float m[8] = {m0.x, m0.y, m0.z, m0.w, m1.x, m1.y, m1.z, m1.w};
#pragma unroll
    for (int j = 0; j < 8; ++j) o[j] = c[j] + m[j] * (wp * pv[j] + wn * nv[j] - c[j]);
}
__device__ __forceinline__ void rw_shift4(const bf16_t* __restrict__ PRW, const float* __restrict__ mu, int r, bool hasp, bool hasn, int col, float (&o)[4]) {
    const bf16_t* p = PRW + (size_t)r * RW_COLS + col;
    float c[4], pv[4], nv[4];
    const float wp = hasp ? 0.5f : 0.f, wn = hasn ? 0.5f : 0.f;
    unpack4(*(const u32x2*)p, c);
    unpack4(*(const u32x2*)(p - (hasp ? RW_COLS : 0)), pv);
    unpack4(*(const u32x2*)(p + (hasn ? RW_COLS : 0)), nv);
    const f32x4 m0 = *(const f32x4*)(mu + col);
    const float m[4] = {m0.x, m0.y, m0.z, m0.w};
#pragma unroll
    for (int j = 0; j < 4; ++j) o[j] = c[j] + m[j] * (wp * pv[j] + wn * nv[j] - c[j]);
}
__device__ __forceinline__ bf16x8 pack_frag(const float (&v)[8]) {
    u32x4 w; w.x = pk2(v[0], v[1]); w.y = pk2(v[2], v[3]); w.z = pk2(v[4], v[5]); w.w = pk2(v[6], v[7]);
    return __builtin_bit_cast(bf16x8, w);
}
__device__ __forceinline__ void phase_rw_prep(const Args& a, int l, int lane, int gw, int nw) {
    const bf16_t* PRW = (const bf16_t*)(a.ws + A_PRW);
    const float* mu = a.in[I_MU] + l * RW_COLS;
    const bf16_t* WUP = (const bf16_t*)(a.ws + WS_WUP); const bf16_t* AUP = (const bf16_t*)(a.ws + WS_AUP); const bf16_t* GUP = (const bf16_t*)(a.ws + WS_GUP);
    const float* w0 = a.in[I_W0] + l * 2 * 512; const float* a0 = a.in[I_A0] + l * 2 * 512;
    const float* k_k = a.in[I_KK] + l * 512; const float* k_a = a.in[I_KA] + l * 512; const float* r_k = a.in[I_RK] + l * 512;
    bf16_t* S_OMW[2] = {(bf16_t*)(a.ws + A_SOMW0), (bf16_t*)(a.ws + A_SOMW1)};
    bf16_t* S_KKA[2] = {(bf16_t*)(a.ws + A_SKKA0), (bf16_t*)(a.ws + A_SKKA1)};
    bf16_t* S_KD[2] = {(bf16_t*)(a.ws + A_SKD0), (bf16_t*)(a.ws + A_SKD1)};
    bf16_t* S_KK = (bf16_t*)(a.ws + A_SKK); bf16_t* S_R = (bf16_t*)(a.ws + A_SR); bf16_t* S_V = (bf16_t*)(a.ws + A_SV); bf16_t* S_G = (bf16_t*)(a.ws + A_SG);
    float* BON = (float*)(a.ws + A_BONUS);
    for (int item = gw; item < RT / 16; item += nw) {
        int lane_ = lane; asm volatile("" : "+v"(lane_));
        int fr = lane_ & 15, fq = lane_ >> 4;
        const int r = item * 16 + fr;
        bool hasp, hasn; rw_seq_bounds(r, hasp, hasn);
        bf16x8 fw[2][2], fa[2][2], fg[4];
#pragma unroll
        for (int d = 0; d < 2; ++d)
#pragma unroll
            for (int ks = 0; ks < 2; ++ks) {
                float v[8];
                rw_shift8(PRW, mu, r, hasp, hasn, 1536 + d * 64 + ks * 32 + fq * 8, v);
#pragma unroll
                for (int j = 0; j < 8; ++j) v[j] = tanhf_(v[j]);
                fw[d][ks] = pack_frag(v);
                __builtin_amdgcn_sched_barrier(0);
                rw_shift8(PRW, mu, r, hasp, hasn, 1664 + d * 64 + ks * 32 + fq * 8, v);
                fa[d][ks] = pack_frag(v);
                __builtin_amdgcn_sched_barrier(0);
            }
#pragma unroll
        for (int ks = 0; ks < 4; ++ks) {
            float v[8];
            rw_shift8(PRW, mu, r, hasp, hasn, 1792 + ks * 32 + fq * 8, v);
#pragma unroll
            for (int j = 0; j < 8; ++j) v[j] = sigmoidf_(v[j]);
            fg[ks] = pack_frag(v);
            __builtin_amdgcn_sched_barrier(0);
        }
#pragma unroll 1
        for (int hh = 0; hh < RW_H; ++hh) {
            asm volatile("" : "+v"(fq), "+v"(fr));
            float ss = 0.f;
#pragma unroll
            for (int nt = 0; nt < 4; ++nt) {
                const int c = hh * 64 + nt * 16 + 4 * fq;
                float kv[4]; rw_shift4(PRW, mu, r, hasp, hasn, 512 + c, kv);
                const f32x4 kk4 = *(const f32x4*)(k_k + c);
                const float q0 = kv[0] * kk4.x, q1 = kv[1] * kk4.y, q2 = kv[2] * kk4.z, q3 = kv[3] * kk4.w;
                ss += (q0 * q0 + q1 * q1) + (q2 * q2 + q3 * q3);
            }
            ss += __shfl_xor(ss, 16); ss += __shfl_xor(ss, 32);
            const float kn = rsqrtf(ss + 1e-12f);
            float bon = 0.f;
#pragma unroll 1
            for (int nt = 0; nt < 4; ++nt) {
                asm volatile("" : "+v"(fq), "+v"(fr));
                const int c0 = hh * 64 + nt * 16;
                f32x4 aw[2], aa[2], ag = {0.f, 0.f, 0.f, 0.f};
#pragma unroll
                for (int d = 0; d < 2; ++d) {
                    aw[d] = (f32x4){0.f, 0.f, 0.f, 0.f}; aa[d] = (f32x4){0.f, 0.f, 0.f, 0.f};
#pragma unroll
                    for (int ks = 0; ks < 2; ++ks) {
                        const bf16x8 bw = *(const bf16x8*)(WUP + (size_t)(d * 512 + c0 + fr) * 64 + ks * 32 + fq * 8);
                        const bf16x8 ba = *(const bf16x8*)(AUP + (size_t)(d * 512 + c0 + fr) * 64 + ks * 32 + fq * 8);
                        aw[d] = __builtin_amdgcn_mfma_f32_16x16x32_bf16(bw, fw[d][ks], aw[d], 0, 0, 0);
                        aa[d] = __builtin_amdgcn_mfma_f32_16x16x32_bf16(ba, fa[d][ks], aa[d], 0, 0, 0);
                    }
                }
#pragma unroll
                for (int ks = 0; ks < 4; ++ks) {
                    const bf16x8 bg = *(const bf16x8*)(GUP + (size_t)(c0 + fr) * 128 + ks * 32 + fq * 8);
                    ag = __builtin_amdgcn_mfma_f32_16x16x32_bf16(bg, fg[ks], ag, 0, 0, 0);
                }
                const int c = c0 + 4 * fq;
                float rv[4], kv[4], vv[4];
                rw_shift4(PRW, mu, r, hasp, hasn, c, rv);
                rw_shift4(PRW, mu, r, hasp, hasn, 512 + c, kv);
                rw_shift4(PRW, mu, r, hasp, hasn, 1024 + c, vv);
                const f32x4 kk4 = *(const f32x4*)(k_k + c), ka4 = *(const f32x4*)(k_a + c), rk4 = *(const f32x4*)(r_k + c);
                float kkv[4];
#pragma unroll
                for (int j = 0; j < 4; ++j) kkv[j] = kv[j] * kk4[j] * kn;
                const size_t o = (size_t)r * 512 + c;
                { u32x2 w; w.x = pk2(kkv[0], kkv[1]); w.y = pk2(kkv[2], kkv[3]); *(u32x2*)(S_KK + o) = w; }
                { u32x2 w; w.x = pk2(rv[0], rv[1]); w.y = pk2(rv[2], rv[3]); *(u32x2*)(S_R + o) = w; }
                { u32x2 w; w.x = pk2(vv[0], vv[1]); w.y = pk2(vv[2], vv[3]); *(u32x2*)(S_V + o) = w; }
                { u32x2 w; w.x = pk2(ag[0], ag[1]); w.y = pk2(ag[2], ag[3]); *(u32x2*)(S_G + o) = w; }
#pragma unroll
                for (int d = 0; d < 2; ++d) {
                    const f32x4 w04 = *(const f32x4*)(w0 + d * 512 + c), a04 = *(const f32x4*)(a0 + d * 512 + c);
                    float omw[4], kka[4], kd[4];
#pragma unroll
                    for (int j = 0; j < 4; ++j) {
                        const float lw = w04[j] + aw[d][j];
                        const float sp = softplusf_(-lw);
                        const float dx = __expf(-sp - 0.5f);
                        omw[j] = 1.0f - __expf(-dx);
                        const float av = sigmoidf_(a04[j] + aa[d][j]);
                        kka[j] = kkv[j] * av;
                        kd[j] = kv[j] * (1.0f + (av - 1.0f) * ka4[j]);
                        bon += rv[j] * kd[j] * rk4[j];
                    }
                    { u32x2 w; w.x = pk2(omw[0], omw[1]); w.y = pk2(omw[2], omw[3]); *(u32x2*)(S_OMW[d] + o) = w; }
                    { u32x2 w; w.x = pk2(kka[0], kka[1]); w.y = pk2(kka[2], kka[3]); *(u32x2*)(S_KKA[d] + o) = w; }
                    { u32x2 w; w.x = pk2(kd[0], kd[1]); w.y = pk2(kd[2], kd[3]); *(u32x2*)(S_KD[d] + o) = w; }
                }
            }
            bon += __shfl_xor(bon, 16); bon += __shfl_xor(bon, 32);
            if (fq == 0) BON[(size_t)r * 8 + hh] = bon;
        }
    }
}

__device__ __forceinline__ int rw_seq_row(int b, int dir, int i) {
    if (i < TC) return RLAT + b * TC + (dir ? TC - 1 - i : i);
    const int j = i - TC; return b * TL + (dir ? TL - 1 - j : j);
}
__device__ __forceinline__ int rw_seq_pos(int dir, int i) {
    if (i < TC) return dir ? TC - 1 - i : i;
    const int j = i - TC; return TC + (dir ? TL - 1 - j : j);
}
__device__ __forceinline__ void phase_rw_scan(const Args& a, LAS unsigned char* lds, int tid, int lane, int wave) {
    const bf16_t* SRC[6];
    bf16_t* Y = (bf16_t*)(a.ws + A_Y);
    for (int cw = blockIdx.x; cw < 256; cw += gridDim.x) {
        const int chain = cw >> 3, rowbase = (cw & 7) * 8;
        const int dir = chain & 1, hh = (chain >> 1) & 7, b = chain >> 4;
        SRC[0] = (const bf16_t*)(a.ws + (dir ? A_SOMW1 : A_SOMW0)); SRC[1] = (const bf16_t*)(a.ws + A_SKK); SRC[2] = (const bf16_t*)(a.ws + (dir ? A_SKKA1 : A_SKKA0));
        SRC[3] = (const bf16_t*)(a.ws + (dir ? A_SKD1 : A_SKD0)); SRC[4] = (const bf16_t*)(a.ws + A_SR); SRC[5] = (const bf16_t*)(a.ws + A_SV);
        const int row = rowbase + wave;
        bf16_t* yrow = Y + ((size_t)(dir * 16 + b * 8 + hh) * 64 + row) * SEQ;
        const int lstep = tid >> 3, lpart = tid & 7;
        u32x4 lr[6];
        {
            const int rr = rw_seq_row(b, dir, lstep);
#pragma unroll
            for (int s = 0; s < 6; ++s) lr[s] = *(const u32x4*)(SRC[s] + (size_t)rr * 512 + hh * 64 + lpart * 8);
#pragma unroll
            for (int s = 0; s < 6; ++s) *(LAS u32x4*)(lds + s * 8192 + lstep * 128 + lpart * 16) = lr[s];
        }
        __syncthreads();
        float S = 0.f;
        constexpr int NBLK = SEQ / 64;
        for (int blk = 0; blk < NBLK; ++blk) {
            LAS unsigned char* cur = lds + (blk & 1) * 49152;
            if (blk + 1 < NBLK) {
                const int rr = rw_seq_row(b, dir, (blk + 1) * 64 + lstep);
#pragma unroll
                for (int s = 0; s < 6; ++s) lr[s] = *(const u32x4*)(SRC[s] + (size_t)rr * 512 + hh * 64 + lpart * 8);
            }
            float ybuf = 0.f;
#pragma unroll 8
            for (int s = 0; s < 64; ++s) {
                const LAS bf16_t* p = (const LAS bf16_t*)cur + s * 64;
                const float omw = bf2f(p[lane]), kk = bf2f(p[4096 + lane]), kka = bf2f(p[2 * 4096 + lane]), kd = bf2f(p[3 * 4096 + lane]), rr_ = bf2f(p[4 * 4096 + lane]);
                const float v = bf2f(p[5 * 4096 + row]);
                const float sa = wave_sum_dpp(S * kk);
                S = fmaf(-omw, S, S);
                S = fmaf(v, kd, S);
                S = fmaf(-sa, kka, S);
                const float y = wave_sum_dpp(S * rr_);
                ybuf = (lane == s) ? y : ybuf;
            }
            yrow[rw_seq_pos(dir, blk * 64 + lane)] = (bf16_t)f2bf(ybuf);
            if (blk + 1 < NBLK) {
                LAS unsigned char* nxt = lds + ((blk + 1) & 1) * 49152;
#pragma unroll
                for (int s = 0; s < 6; ++s) *(LAS u32x4*)(nxt + s * 8192 + lstep * 128 + lpart * 16) = lr[s];
            }
            __syncthreads();
        }
    }
}

__device__ __forceinline__ void phase_rw_out(const Args& a, int l, bool need_ctx, int lane, int gw, int nw) {
    const bf16_t* Y = (const bf16_t*)(a.ws + A_Y);
    const bf16_t* S_V = (const bf16_t*)(a.ws + A_SV); const bf16_t* S_G = (const bf16_t*)(a.ws + A_SG);
    const float* BON = (const float*)(a.ws + A_BONUS);
    bf16_t* BL = (bf16_t*)(a.ws + A_BLAT);
    const float* lnw = a.in[I_LNW] + l * 512; const float* lnb = a.in[I_LNB] + l * 512;
    for (int item = gw; item < 16 * NCH; item += nw) {
        const int bh = item / NCH, pb = item % NCH, b = bh >> 3, hh = bh & 7;
        if (pb < 4 && !need_ctx) continue;
        const int pos = pb * 64 + lane;
        const int r = (pb < 4) ? RLAT + b * TC + pos : b * TL + (pos - TC);
        const bf16_t* yf = Y + ((size_t)(0 * 16 + bh) * 64) * SEQ + pos;
        const bf16_t* yb = Y + ((size_t)(1 * 16 + bh) * 64) * SEQ + pos;
        float y[64]; float s = 0.f;
#pragma unroll
        for (int i = 0; i < 64; ++i) { y[i] = bf2f(yf[(size_t)i * SEQ]) + bf2f(yb[(size_t)i * SEQ]); s += y[i]; }
        const float mean = s * (1.0f / 64.0f);
        float q = 0.f;
#pragma unroll
        for (int i = 0; i < 64; ++i) { const float d = y[i] - mean; q += d * d; }
        const float rstd = rsqrtf(q * (1.0f / 64.0f) + RW_GN_EPS);
        const float bon = BON[(size_t)r * 8 + hh];
        const size_t o = (size_t)r * 512 + hh * 64;
#pragma unroll
        for (int c8 = 0; c8 < 8; ++c8) {
            float vv[8], gg[8];
            unpack8(*(const u32x4*)(S_V + o + c8 * 8), vv); unpack8(*(const u32x4*)(S_G + o + c8 * 8), gg);
            const f32x4 w0 = *(const f32x4*)(lnw + hh * 64 + c8 * 8), w1 = *(const f32x4*)(lnw + hh * 64 + c8 * 8 + 4);
            const f32x4 b0 = *(const f32x4*)(lnb + hh * 64 + c8 * 8), b1 = *(const f32x4*)(lnb + hh * 64 + c8 * 8 + 4);
            const float lw[8] = {w0.x, w0.y, w0.z, w0.w, w1.x, w1.y, w1.z, w1.w}, lb[8] = {b0.x, b0.y, b0.z, b0.w, b1.x, b1.y, b1.z, b1.w};
            float ov[8];
#pragma unroll
            for (int j = 0; j < 8; ++j) ov[j] = ((y[c8 * 8 + j] - mean) * rstd * lw[j] + lb[j] + bon * vv[j]) * gg[j];
            u32x4 w; w.x = pk2(ov[0], ov[1]); w.y = pk2(ov[2], ov[3]); w.z = pk2(ov[4], ov[5]); w.w = pk2(ov[6], ov[7]);
            *(u32x4*)(BL + o + c8 * 8) = w;
        }
    }
}

__device__ __forceinline__ void phase_merge1(const Args& a, bool need_ctx, LAS unsigned char* lds, int tid, int lane, int wave) {
    LAS bf16_t* sm = (LAS bf16_t*)lds;
    const bf16_t* AL = (const bf16_t*)(a.ws + A_ALAT); const bf16_t* BL = (const bf16_t*)(a.ws + A_BLAT);
    const bf16_t* WPA = (const bf16_t*)(a.ws + WS_WPA); const bf16_t* WPB = (const bf16_t*)(a.ws + WS_WPB);
    const bf16_t* PGT = (const bf16_t*)(a.ws + A_PGT);
    bf16_t* U = (bf16_t*)(a.ws + A_U);
    const int wm = wave >> 2, wn = wave & 3, fr = lane & 15, fq = lane >> 4;
    const int srow = tid >> 3, skc = tid & 7;
    const int NM = (need_ctx ? RT : RLAT) / 128;
    for (int tile = blockIdx.x; tile < NM * 8; tile += gridDim.x) {
        const int tm = tile >> 3, tn = tile & 7;
        f32x4 acc[4][2], acc2[4][2]; ZERO_ACC(acc); ZERO_ACC(acc2);
        {
            const bf16_t* pa0 = AL + (size_t)(tm * 128 + srow) * 512 + skc * 8;
            const bf16_t* pb0 = WPA + (size_t)(tn * 128 + srow) * 512 + skc * 8;
            gemm_tile(sm, pa0, pa0 + (size_t)64 * 512, pb0, pb0 + (size_t)64 * 512, 8, acc, tid, lane, wm, wn);
        }
        {
            const bf16_t* pa0 = BL + (size_t)(tm * 128 + srow) * 512 + skc * 8;
            const bf16_t* pb0 = WPB + (size_t)(tn * 128 + srow) * 512 + skc * 8;
            gemm_tile(sm, pa0, pa0 + (size_t)64 * 512, pb0, pb0 + (size_t)64 * 512, 8, acc2, tid, lane, wm, wn);
        }
#pragma unroll
        for (int mi = 0; mi < 4; ++mi) {
            const int row = tm * 128 + wm * 64 + mi * 16 + fr;
#pragma unroll
            for (int ni = 0; ni < 2; ++ni) {
                const int nc = tn * 128 + wn * 32 + ni * 16 + 4 * fq;
                float ga[4], gb[4];
                unpack4(*(const u32x2*)(PGT + (size_t)row * GT_COLS + nc), ga);
                unpack4(*(const u32x2*)(PGT + (size_t)row * GT_COLS + 1024 + nc), gb);
                float o[4];
#pragma unroll
                for (int j = 0; j < 4; ++j) o[j] = sigmoidf_(ga[j]) * acc[mi][ni][j] + sigmoidf_(gb[j]) * acc2[mi][ni][j];
                u32x2 w; w.x = pk2(o[0], o[1]); w.y = pk2(o[2], o[3]);
                *(u32x2*)(U + (size_t)row * D + nc) = w;
            }
        }
    }
}
__device__ __forceinline__ void phase_merge2(const Args& a, int l, bool need_ctx, LAS unsigned char* lds, int tid, int lane, int wave) {
    LAS bf16_t* sm = (LAS bf16_t*)lds;
    const bf16_t* U = (const bf16_t*)(a.ws + A_U); const bf16_t* WO = (const bf16_t*)(a.ws + WS_WOUT);
    const float* MOD = (const float*)(a.ws + WS_MOD);
    const int wm = wave >> 2, wn = wave & 3, fr = lane & 15, fq = lane >> 4;
    const int srow = tid >> 3, skc = tid & 7;
    const int NM = (need_ctx ? RT : RLAT) / 128;
    for (int tile = blockIdx.x; tile < NM * 8; tile += gridDim.x) {
        const int tm = tile >> 3, tn = tile & 7;
        f32x4 acc[4][2]; ZERO_ACC(acc);
        const bf16_t* pa0 = U + (size_t)(tm * 128 + srow) * D + skc * 8;
        const bf16_t* pb0 = WO + (size_t)(tn * 128 + srow) * D + skc * 8;
        gemm_tile(sm, pa0, pa0 + (size_t)64 * D, pb0, pb0 + (size_t)64 * D, 16, acc, tid, lane, wm, wn);
#pragma unroll
        for (int mi = 0; mi < 4; ++mi) {
            const int row = tm * 128 + wm * 64 + mi * 16 + fr;
            const float* g1 = MOD + ((size_t)l * 3 + row_mv(row)) * 6144 + 2048;
            const float* xi = xrow_in(a, l, row); float* xo = xrow_out(a, row);
#pragma unroll
            for (int ni = 0; ni < 2; ++ni) {
                const int nc = tn * 128 + wn * 32 + ni * 16 + 4 * fq;
                const f32x4 g = *(const f32x4*)(g1 + nc), x = *(const f32x4*)(xi + nc);
                f32x4 o; o.x = x.x + g.x * acc[mi][ni][0]; o.y = x.y + g.y * acc[mi][ni][1]; o.z = x.z + g.z * acc[mi][ni][2]; o.w = x.w + g.w * acc[mi][ni][3];
                *(f32x4*)(xo + nc) = o;
            }
        }
    }
}

__device__ __forceinline__ void phase_router(const Args& a, int l, bool need_ctx, LAS unsigned char* lds, int tid, int lane, int wave) {
    LAS float* Wt = (LAS float*)lds;
    LAS int* se = (LAS int*)(lds + 65536);
    for (int i = tid; i < 16 * 1024; i += 512) { const int k = i >> 4, e = i & 15; Wt[e * 1024 + k] = a.in[I_RTW][i]; }
    __syncthreads();
    const float* MOD = (const float*)(a.ws + WS_MOD);
    bf16_t* H2 = (bf16_t*)(a.ws + A_H2);
    unsigned* cnt = (unsigned*)(a.ws + WS_CTL) + CW_CNT + l * 16;
    int* LIST = (int*)(a.ws + A_LIST); float* TOKW = (float*)(a.ws + A_TOKW);
    const int nrows = need_ctx ? RT : RLAT;
    const int rp = (nrows + (int)gridDim.x - 1) / (int)gridDim.x;
    const int r0 = blockIdx.x * rp;
    for (int i = wave; i < rp; i += 8) {
        const int r = r0 + i;
        if (r >= nrows) { if (lane == 0) { se[i * 2] = -1; se[i * 2 + 1] = -1; } continue; }
        const float* xr = (r < RLAT) ? a.out + (size_t)r * D : (const float*)(a.ws + WS_XCTX) + (size_t)(r - RLAT) * D;
        f32x4 v[4], h[4];
#pragma unroll
        for (int j = 0; j < 4; ++j) v[j] = *(const f32x4*)(xr + 4 * lane + 256 * j);
        const float* m = MOD + ((size_t)l * 3 + row_mv(r)) * 6144;
        norm_mod_row(v, a.in[I_N2G] + l * D, m + 3072, m + 4096, H2 + (size_t)r * D, lane, h);
        int i1 = 0, i2 = 0; float c1 = 0.f, c2 = 0.f, bestv = -1e30f;
#pragma unroll 1
        for (int g = 0; g < 4; ++g) {
            float m1 = -1e30f, m2 = -1e30f, q1 = 0.f, q2 = 0.f; int j1 = 0, j2 = 0;
#pragma unroll
            for (int jj = 0; jj < 4; ++jj) {
                const int e = g * 4 + jj;
                float p = 0.f;
#pragma unroll
                for (int j = 0; j < 4; ++j) { const f32x4 w = *(const LAS f32x4*)(Wt + e * 1024 + 256 * j + 4 * lane); p += (h[j].x * w.x + h[j].y * w.y) + (h[j].z * w.z + h[j].w * w.w); }
                const float sc = sigmoidf_(wave_sum_dpp(p));
                const float x = sc + a.in[I_RTB][e];
                if (x > m1) { m2 = m1; j2 = j1; q2 = q1; m1 = x; j1 = e; q1 = sc; } else if (x > m2) { m2 = x; j2 = e; q2 = sc; }
            }
            const float gs = m1 + m2;
            if (gs > bestv) { bestv = gs; i1 = j1; i2 = j2; c1 = q1; c2 = q2; }
        }
        if (lane == 0) {
            const float inv = 1.0f / (c1 + c2);
            se[i * 2] = i1; se[i * 2 + 1] = i2;
            TOKW[(size_t)r * 2] = c1 * inv; TOKW[(size_t)r * 2 + 1] = c2 * inv;
        }
    }
    __syncthreads();
    if (tid < 16) {
        int c = 0;
        for (int i = 0; i < rp * 2; ++i) c += (se[i] == tid) ? 1 : 0;
        unsigned p = atomicAdd(cnt + tid, (unsigned)c);
        for (int i = 0; i < rp * 2; ++i) if (se[i] == tid) { LIST[(size_t)tid * RT + p] = (r0 + (i >> 1)) * 2 + (i & 1); ++p; }
    }
    __syncthreads();
}

__device__ __forceinline__ void moe_counts(const Args& a, int l, int (&cn)[16], int (&base)[16], int (&mtc)[17]) {
    const unsigned* cnt = (const unsigned*)(a.ws + WS_CTL) + CW_CNT + l * 16;
    int s = 0, t = 0;
#pragma unroll
    for (int e = 0; e < 16; ++e) { cn[e] = (int)__hip_atomic_load(cnt + e, __ATOMIC_RELAXED, __HIP_MEMORY_SCOPE_AGENT); base[e] = s; s += cn[e]; mtc[e] = t; t += (cn[e] + 127) >> 7; }
    mtc[16] = t;
}
__device__ __forceinline__ void phase_moe_up(const Args& a, int l, LAS unsigned char* lds, int tid, int lane, int wave) {
    LAS bf16_t* sm = (LAS bf16_t*)lds;
    int cn[16], base[16], mtc[17]; moe_counts(a, l, cn, base, mtc);
    const int* LIST = (const int*)(a.ws + A_LIST);
    const bf16_t* H2 = (const bf16_t*)(a.ws + A_H2);
    const bf16_t* WG = (const bf16_t*)(a.ws + A_WG); const bf16_t* WU = (const bf16_t*)(a.ws + A_WU);
    bf16_t* HID = (bf16_t*)(a.ws + A_HID);
    const int wm = wave >> 2, wn = wave & 3, fr = lane & 15, fq = lane >> 4;
    const int srow = tid >> 3, skc = tid & 7;
    const int ntile = mtc[16] * 4;
    for (int tile = blockIdx.x; tile < ntile; tile += gridDim.x) {
        const int mtg = tile >> 2, tn = tile & 3;
        int e = 0;
#pragma unroll
        for (int i = 1; i < 16; ++i) if (mtg >= mtc[i]) e = i;
        int cne = 0, be = 0, mt0 = 0;
#pragma unroll
        for (int i = 0; i < 16; ++i) if (i == e) { cne = cn[i]; be = base[i]; mt0 = mtc[i]; }
        const int m0 = (mtg - mt0) * 128;
        const int i0 = min(m0 + srow, cne - 1), i1 = min(m0 + srow + 64, cne - 1);
        const int tok0 = LIST[(size_t)e * RT + i0] >> 1, tok1 = LIST[(size_t)e * RT + i1] >> 1;
        const bf16_t* pa0 = H2 + (size_t)tok0 * D + skc * 8;
        const bf16_t* pa1 = H2 + (size_t)tok1 * D + skc * 8;
        f32x4 acc[4][2], acc2[4][2]; ZERO_ACC(acc); ZERO_ACC(acc2);
        {
            const bf16_t* pb0 = WG + ((size_t)e * DE + tn * 128 + srow) * D + skc * 8;
            gemm_tile(sm, pa0, pa1, pb0, pb0 + (size_t)64 * D, 16, acc, tid, lane, wm, wn);
        }
        {
            const bf16_t* pb0 = WU + ((size_t)e * DE + tn * 128 + srow) * D + skc * 8;
            gemm_tile(sm, pa0, pa1, pb0, pb0 + (size_t)64 * D, 16, acc2, tid, lane, wm, wn);
        }
#pragma unroll
        for (int mi = 0; mi < 4; ++mi) {
            const int li = m0 + wm * 64 + mi * 16 + fr;
            if (li < cne) {
#pragma unroll
                for (int ni = 0; ni < 2; ++ni) {
                    const int nc = tn * 128 + wn * 32 + ni * 16 + 4 * fq;
                    float o[4];
#pragma unroll
                    for (int j = 0; j < 4; ++j) o[j] = siluf_(acc[mi][ni][j]) * acc2[mi][ni][j];
                    u32x2 w; w.x = pk2(o[0], o[1]); w.y = pk2(o[2], o[3]);
                    *(u32x2*)(HID + (size_t)(be + li) * DE + nc) = w;
                }
            }
        }
    }
}
__device__ __forceinline__ void phase_moe_down(const Args& a, int l, LAS unsigned char* lds, int tid, int lane, int wave) {
    LAS bf16_t* sm = (LAS bf16_t*)lds;
    int cn[16], base[16], mtc[17]; moe_counts(a, l, cn, base, mtc);
    const int* LIST = (const int*)(a.ws + A_LIST); const float* TOKW = (const float*)(a.ws + A_TOKW);
    const bf16_t* HID = (const bf16_t*)(a.ws + A_HID); const bf16_t* WD = (const bf16_t*)(a.ws + A_WD);
    bf16_t* CON = (bf16_t*)(a.ws + A_CONTRIB);
    const int wm = wave >> 2, wn = wave & 3, fr = lane & 15, fq = lane >> 4;
    const int srow = tid >> 3, skc = tid & 7;
    const int ntile = mtc[16] * 8;
    for (int tile = blockIdx.x; tile < ntile; tile += gridDim.x) {
        const int mtg = tile >> 3, tn = tile & 7;
        int e = 0;
#pragma unroll
        for (int i = 1; i < 16; ++i) if (mtg >= mtc[i]) e = i;
        int cne = 0, be = 0, mt0 = 0;
#pragma unroll
        for (int i = 0; i < 16; ++i) if (i == e) { cne = cn[i]; be = base[i]; mt0 = mtc[i]; }
        const int m0 = (mtg - mt0) * 128;
        const int i0 = min(m0 + srow, cne - 1), i1 = min(m0 + srow + 64, cne - 1);
        const bf16_t* pa0 = HID + (size_t)(be + i0) * DE + skc * 8;
        const bf16_t* pa1 = HID + (size_t)(be + i1) * DE + skc * 8;
        const bf16_t* pb0 = WD + ((size_t)e * D + tn * 128 + srow) * DE + skc * 8;
        f32x4 acc[4][2]; ZERO_ACC(acc);
        gemm_tile(sm, pa0, pa1, pb0, pb0 + (size_t)64 * DE, 8, acc, tid, lane, wm, wn);
#pragma unroll
        for (int mi = 0; mi < 4; ++mi) {
            const int li = m0 + wm * 64 + mi * 16 + fr;
            if (li < cne) {
                const int ent = LIST[(size_t)e * RT + li];
                const float w = TOKW[ent];
                bf16_t* dst = CON + ((size_t)(ent & 1) * RT + (ent >> 1)) * D;
#pragma unroll
                for (int ni = 0; ni < 2; ++ni) {
                    const int nc = tn * 128 + wn * 32 + ni * 16 + 4 * fq;
                    u32x2 o; o.x = pk2(w * acc[mi][ni][0], w * acc[mi][ni][1]); o.y = pk2(w * acc[mi][ni][2], w * acc[mi][ni][3]);
                    *(u32x2*)(dst + nc) = o;
                }
            }
        }
    }
}
__device__ __forceinline__ void phase_combine(const Args& a, int l, bool need_ctx, bool last, int lane, int gw, int nw) {
    const float* MOD = (const float*)(a.ws + WS_MOD);
    const bf16_t* CON = (const bf16_t*)(a.ws + A_CONTRIB);
    bf16_t* H = (bf16_t*)(a.ws + A_H);
    const int nrows = need_ctx ? RT : RLAT;
    for (int r = gw; r < nrows; r += nw) {
        float* xr = xrow_out(a, r);
        const float* g2 = MOD + ((size_t)l * 3 + row_mv(r)) * 6144 + 5120;
        f32x4 v[4];
#pragma unroll
        for (int j = 0; j < 4; ++j) {
            const int idx = 4 * lane + 256 * j;
            v[j] = *(const f32x4*)(xr + idx);
            float c0[4], c1[4];
            unpack4(*(const u32x2*)(CON + (size_t)r * D + idx), c0); unpack4(*(const u32x2*)(CON + ((size_t)RT + r) * D + idx), c1);
            const f32x4 g = *(const f32x4*)(g2 + idx);
            v[j].x += g.x * (c0[0] + c1[0]); v[j].y += g.y * (c0[1] + c1[1]); v[j].z += g.z * (c0[2] + c1[2]); v[j].w += g.w * (c0[3] + c1[3]);
        }
        if (!last) {
#pragma unroll
            for (int j = 0; j < 4; ++j) *(f32x4*)(xr + 4 * lane + 256 * j) = v[j];
            f32x4 h[4];
            const float* m = MOD + ((size_t)(l + 1) * 3 + row_mv(r)) * 6144;
            norm_mod_row(v, a.in[I_N1G] + (l + 1) * D, m, m + 1024, H + (size_t)r * D, lane, h);
        } else {
            float s = 0.f;
#pragma unroll
            for (int j = 0; j < 4; ++j) s += (v[j].x * v[j].x + v[j].y * v[j].y) + (v[j].z * v[j].z + v[j].w * v[j].w);
            s = wave_sum_shfl(s);
            const float rstd = rsqrtf(s * (1.0f / D) + NORM_EPS);
#pragma unroll
            for (int j = 0; j < 4; ++j) {
                const int idx = 4 * lane + 256 * j;
                const f32x4 g = *(const f32x4*)(a.in[I_FG] + idx);
                f32x4 o; o.x = v[j].x * rstd * g.x; o.y = v[j].y * rstd * g.y; o.z = v[j].z * rstd * g.z; o.w = v[j].w * rstd * g.w;
                *(f32x4*)(xr + idx) = o;
            }
        }
    }
}

__global__ void __launch_bounds__(512) mega(Args a_in) {
    extern __shared__ __attribute__((aligned(16))) unsigned char lds_raw[];
    LAS unsigned char* lds = (LAS unsigned char*)lds_raw;
    volatile LAS unsigned* misc = (volatile LAS unsigned*)(lds + LDS_MISC);
    if (threadIdx.x < 64) misc[threadIdx.x] = 0u;
    __syncthreads();
    const bool multi = (a_in.ph_hi - a_in.ph_lo) > 1;
    XcdBarrier bar; bar.bar = (unsigned*)(a_in.ws + WS_CTL) + CW_BAR; bar.x = 0; bar.st = misc;
    if (multi) bar = xcd_barrier_post((unsigned*)(a_in.ws + WS_CTL) + CW_BAR, misc);

    const Args& a0 = a_in;
    for (int ph = a0.ph_lo; ph < a0.ph_hi; ++ph) {
        Args a = a0;
        { unsigned long long w_ = (unsigned long long)a.ws; asm volatile("" : "+s"(w_)); a.ws = (unsigned char*)w_; }
        { unsigned long long w_ = (unsigned long long)a.out; asm volatile("" : "+s"(w_)); a.out = (float*)w_; }
        int tid = threadIdx.x; asm volatile("" : "+v"(tid));
        const int lane = tid & 63, wave = __builtin_amdgcn_readfirstlane(tid >> 6);
        const int gw = blockIdx.x * 8 + wave, nw = gridDim.x * 8;
        if (ph == 0 && SUB_ON(100)) {
            REP(100) { phase_mod(a, lds, tid, lane, wave);
            for (int it = gw; it < CONV_CORE_ITEMS; it += nw) conv_core(a, 0, it, lane); }
        } else if (ph == 1 && SUB_ON(101)) {
            phase_norm1(a, 0, lane, gw, nw);
        } else if (ph >= 2) {
            const int l = (ph - 2) / 13, sub = (ph - 2) % 13;
            const bool last = (l == 1), need_ctx = !last;
            switch (sub) {
            case 0: if (!SUB_ON(0)) break; REP(0) phase_inproj(a, lds, tid, lane, wave); break;
            case 1: if (!SUB_ON(1)) break; REP(1) phase_ml_a(a, l, lds, tid, lane, wave); break;
            case 2: if (!SUB_ON(2)) break; phase_ml_b(a, tid); break;
            case 3: if (!SUB_ON(3)) break; REP(3) phase_ml_c(a, l, need_ctx, lds, tid, lane, wave); break;
            case 4: if (!SUB_ON(4)) break; REP(4) phase_rw_prep(a, l, lane, gw, nw); break;
            case 5: if (!SUB_ON(5)) break; REP(5) phase_rw_scan(a, lds, tid, lane, wave); break;
            case 6: if (!SUB_ON(6)) break; REP(6) phase_rw_out(a, l, need_ctx, lane, gw, nw); break;
            case 7: if (!SUB_ON(7)) break; REP(7) phase_merge1(a, need_ctx, lds, tid, lane, wave);
                    REP(77) for (int it = gw; it < CONV_EXP_ITEMS; it += nw) conv_exp(a, l, it, lane);
                    break;
            case 8: if (!SUB_ON(8)) break; REP(8) { if (rep_ == 0 || l == 0) phase_merge2(a, l, need_ctx, lds, tid, lane, wave); } break;
            case 9: if (!SUB_ON(9)) break; phase_router(a, l, need_ctx, lds, tid, lane, wave); break;
            case 10: if (!SUB_ON(10)) break; REP(10) phase_moe_up(a, l, lds, tid, lane, wave); break;
            case 11: if (!SUB_ON(11)) break; REP(11) phase_moe_down(a, l, lds, tid, lane, wave); break;
            default: if (!SUB_ON(12)) break; phase_combine(a, l, need_ctx, last, lane, gw, nw);
                     if (!last) for (int it = gw; it < CONV_CORE_ITEMS; it += nw) conv_core(a, l + 1, it, lane);
                     break;
            }
        }
        if (ph + 1 < a0.ph_hi) { xcd_barrier(bar); if (PROBE_SUB == 99) xcd_barrier(bar); }
    }
}
}

extern "C" void kernel_launch(void* const* d_in, const int* in_sizes, int n_in, void* d_out, int out_size, void* d_ws, size_t ws_size, hipStream_t stream) {
    static int grid = 0;
    if (grid == 0) {
        if (n_in != 33 || in_sizes[0] != RLAT * D || out_size != RLAT * D || ws_size < WS_NEED) {
            fprintf(stderr, "kernel_launch: unexpected shapes / workspace: n_in %d in0 %d out %d ws %zu (need %zu)\n", n_in, n_in > 0 ? in_sizes[0] : -1, out_size, ws_size, (size_t)WS_NEED);
            grid = -1; return;
        }
        int dev = 0, cus = 0;
        if (hipGetDevice(&dev) != hipSuccess || hipDeviceGetAttribute(&cus, hipDeviceAttributeMultiprocessorCount, dev) != hipSuccess) { grid = -1; return; }
        if (hipFuncSetAttribute((const void*)mega, hipFuncAttributeMaxDynamicSharedMemorySize, LDS_BYTES) != hipSuccess) { fprintf(stderr, "kernel_launch: hipFuncSetAttribute failed\n"); grid = -1; return; }
        (void)hipGetLastError();
        grid = cus;
    }
    if (grid < 0) return;
    (void)hipMemsetAsync((char*)d_ws + WS_CTL, 0, CTL_BYTES, stream);
    Args a{};
    for (int i = 0; i < 33; ++i) a.in[i] = (const float*)d_in[i];
    a.out = (float*)d_out; a.ws = (unsigned char*)d_ws;
#if MK_PER_PHASE
    for (int ph = 0; ph < NPHASE; ++ph) { a.ph_lo = ph; a.ph_hi = ph + 1; hipLaunchKernelGGL(mega, dim3(grid), dim3(512), LDS_BYTES, stream, a); }
#else
    a.ph_lo = 0; a.ph_hi = NPHASE;
    hipLaunchKernelGGL(mega, dim3(grid), dim3(512), LDS_BYTES, stream, a);
#endif
}
```

```cpp
#include <hip/hip_runtime.h>
#include <cstdio>
#include <cstdint>

#ifndef MK_PER_PHASE
#define MK_PER_PHASE 0
#endif

#ifndef ONLY_SUB
#define ONLY_SUB -1
#endif
#define SUB_ON(k) (ONLY_SUB < 0 || ONLY_SUB == (k))
#ifndef PROBE_SUB
#define PROBE_SUB -1
#endif
#define REP(k) for (int rep_ = 0; rep_ < ((PROBE_SUB == (k)) ? 2 : 1); ++rep_)
#define LAS __attribute__((address_space(3)))
typedef unsigned short bf16_t;
typedef short bf16x8 __attribute__((ext_vector_type(8)));
typedef float f32x4 __attribute__((ext_vector_type(4)));
typedef unsigned u32x4 __attribute__((ext_vector_type(4)));
typedef unsigned u32x2 __attribute__((ext_vector_type(2)));

namespace {
constexpr int D = 1024, NBATCH = 2, TL = 8192, TC = 256;
constexpr int RLAT = NBATCH * TL, RCTX = NBATCH * TC, RT = RLAT + RCTX;
constexpr int ML_H = 4, ML_COLS = 1552;
constexpr int RW_H = 8, RW_W = 512, RW_COLS = 1920, GT_COLS = 2048, IN_COLS = 5520, IN_PAD = 5632;
constexpr int NE = 16, DE = 512;
constexpr int NCH = 132;
constexpr int SEQ = TC + TL;
constexpr float NORM_EPS = 1e-6f, GATE_CAP = 15.0f, RW_GN_EPS = 6.4e-4f;
constexpr int NPHASE = 28;

constexpr size_t WS_CTL = 0;
constexpr size_t CTL_BYTES = 65536;
constexpr size_t CW_BAR = 0;
constexpr size_t CW_CNT = 4096;
constexpr size_t WS_MOD = WS_CTL + CTL_BYTES;
constexpr size_t WS_XCTX = WS_MOD + 163840;
constexpr size_t WS_WIN = WS_XCTX + (size_t)RCTX * D * 4;
constexpr size_t WS_WPA = WS_WIN + (size_t)IN_PAD * D * 2;
constexpr size_t WS_WPB = WS_WPA + (size_t)D * 512 * 2;
constexpr size_t WS_WOUT = WS_WPB + (size_t)D * 512 * 2;
constexpr size_t WS_WUP = WS_WOUT + (size_t)D * D * 2;
constexpr size_t WS_AUP = WS_WUP + 2 * 512 * 64 * 2;
constexpr size_t WS_GUP = WS_AUP + 2 * 512 * 64 * 2;
constexpr size_t WS_ARENA = WS_GUP + 512 * 128 * 2;
constexpr size_t SZ_PGT = (size_t)RT * GT_COLS * 2, SZ_PRW = (size_t)RT * RW_COLS * 2, SZ_PML = (size_t)RT * ML_COLS * 2;
constexpr size_t SZ_R1K = (size_t)RT * D * 2;
constexpr size_t SZ_R512 = (size_t)RT * 512 * 2;
constexpr size_t A_PGT = WS_ARENA;
constexpr size_t A_PRW = A_PGT + SZ_PGT;
constexpr size_t A_PML = A_PRW + SZ_PRW;
constexpr size_t A_H = A_PML + SZ_PML;
constexpr size_t A_DC = A_H;
constexpr size_t A_DN = A_DC + (size_t)16 * NCH * 8192 * 4;
constexpr size_t A_G = A_DN + (size_t)16 * NCH * 64 * 4;
constexpr size_t A_ALAT = A_G + (size_t)16 * NCH * 4;
constexpr int RW_ITEMS = 32 * NCH;
constexpr size_t A_RG = A_PML;
constexpr size_t A_RYC = A_RG + (size_t)RW_ITEMS * 8192;
constexpr size_t A_RYL = A_RYC + (size_t)RW_ITEMS * 8192;
constexpr size_t A_BLAT = A_RYL + (size_t)RW_ITEMS * 8192;
static_assert(A_BLAT + SZ_R512 <= A_DN, "rwkv overlay");
constexpr size_t A_RH = A_ALAT + SZ_R512;
constexpr size_t A_BONUS = A_RH + (size_t)RW_ITEMS * 16384;
constexpr size_t A_END = A_BONUS + (size_t)2 * RT * 8 * 4;
constexpr size_t A_U = A_PML;
constexpr size_t A_H2 = A_U + SZ_R1K;
constexpr size_t A_WG = A_H2 + SZ_R1K;
constexpr size_t A_WU = A_WG + (size_t)NE * DE * D * 2;
constexpr size_t A_WD = A_WU + (size_t)NE * DE * D * 2;
static_assert(A_WD + (size_t)NE * DE * D * 2 <= A_DN, "expert weight overlay");
constexpr size_t A_LIST = A_ALAT;
constexpr size_t A_TOKW = A_LIST + (size_t)NE * RT * 4;
static_assert(A_TOKW + (size_t)RT * 8 <= A_RH, "list overlay");
constexpr size_t A_HID = A_PGT;
constexpr size_t A_CONTRIB = A_HID + (size_t)2 * RT * DE * 2;
static_assert(A_CONTRIB + (size_t)2 * RT * D * 2 <= A_PML, "contrib overlay");
constexpr size_t WS_NEED = A_END;

constexpr int LDS_BYTES = 147456;
constexpr int LDS_MISC = 147456 - 256;

__device__ __forceinline__ float bf2f(unsigned h) { return __uint_as_float(h << 16); }
__device__ __forceinline__ unsigned f2bf(float f) { unsigned u = __float_as_uint(f); return (u + 0x7fffu + ((u >> 16) & 1u)) >> 16; }
__device__ __forceinline__ unsigned pk2(float lo, float hi) { return f2bf(lo) | (f2bf(hi) << 16); }
__device__ __forceinline__ float sigmoidf_(float x) { return 1.0f / (1.0f + __expf(-x)); }
__device__ __forceinline__ float siluf_(float x) { return x / (1.0f + __expf(-x)); }
__device__ __forceinline__ float tanhf_(float x) { return 1.0f - 2.0f / (__expf(2.0f * x) + 1.0f); }
__device__ __forceinline__ float softplusf_(float x) { return fmaxf(x, 0.f) + __logf(1.0f + __expf(-fabsf(x))); }
__device__ __forceinline__ float wave_sum_shfl(float v) {
#pragma unroll
    for (int o = 1; o < 64; o <<= 1) v += __shfl_xor(v, o);
    return v;
}
template <int CTRL> __device__ __forceinline__ float dpp_mov(float v) {
    return __int_as_float(__builtin_amdgcn_update_dpp(0, __float_as_int(v), CTRL, 0xf, 0xf, true));
}
__device__ __forceinline__ float wave_sum_dpp(float v) {
    v += dpp_mov<0xB1>(v);
    v += dpp_mov<0x4E>(v);
    v += dpp_mov<0x141>(v);
    v += dpp_mov<0x140>(v);
    { auto r = __builtin_amdgcn_permlane16_swap(__float_as_uint(v), __float_as_uint(v), false, false); unsigned a = r[0], b = r[1]; v = __uint_as_float(a) + __uint_as_float(b); }
    { auto r = __builtin_amdgcn_permlane32_swap(__float_as_uint(v), __float_as_uint(v), false, false); unsigned a = r[0], b = r[1]; v = __uint_as_float(a) + __uint_as_float(b); }
    return v;
}
__device__ __forceinline__ void unpack8(u32x4 w, float (&o)[8]) {
    o[0] = bf2f(w.x & 0xffffu); o[1] = __uint_as_float(w.x & 0xffff0000u); o[2] = bf2f(w.y & 0xffffu); o[3] = __uint_as_float(w.y & 0xffff0000u);
    o[4] = bf2f(w.z & 0xffffu); o[5] = __uint_as_float(w.z & 0xffff0000u); o[6] = bf2f(w.w & 0xffffu); o[7] = __uint_as_float(w.w & 0xffff0000u);
}
__device__ __forceinline__ void unpack4(u32x2 w, float (&o)[4]) {
    o[0] = bf2f(w.x & 0xffffu); o[1] = __uint_as_float(w.x & 0xffff0000u); o[2] = bf2f(w.y & 0xffffu); o[3] = __uint_as_float(w.y & 0xffff0000u);
}

#define XB_TMO      128
#define XB_XCNT(j)  (256  + 64 * (j))
#define XB_XSUB(j)  (1280 + 64 * (j))
#define XB_XGEN(j)  (2304 + 64 * (j))
#define XB_TOP      3328
#define XB_TOPGEN   3392
#define XCD_BAR_WORDS 3456
#define XB_SPIN_CAP (1u << 24)
__device__ __forceinline__ unsigned xb_ld(unsigned* p)              { return __hip_atomic_load(p, __ATOMIC_RELAXED, __HIP_MEMORY_SCOPE_AGENT); }
__device__ __forceinline__ unsigned xb_add(unsigned* p, unsigned v) { return __hip_atomic_fetch_add(p, v, __ATOMIC_RELAXED, __HIP_MEMORY_SCOPE_AGENT); }
__device__ __forceinline__ unsigned xb_xcc_id() { return (unsigned)__builtin_amdgcn_s_getreg((3 << 11) | 20) & 0xFu; }
#define XB_SPIN(cond, bar) do { unsigned _sp = 0; while (cond) { __builtin_amdgcn_s_sleep(1); \
    if ((++_sp & 255u) == 0u) { if (xb_ld(&(bar)[XB_TMO])) break; if (_sp > XB_SPIN_CAP) { atomicAdd(&(bar)[XB_TMO], 1u); break; } } } } while (0)
struct XcdBarrier { unsigned* bar; unsigned x; volatile LAS unsigned* st; };
__device__ __forceinline__ XcdBarrier xcd_barrier_post(unsigned* bar, volatile LAS unsigned* st) {
    XcdBarrier b; b.bar = bar; b.x = xb_xcc_id(); b.st = st;
    if (threadIdx.x == 0) (void)xb_add(&bar[XB_XCNT(b.x)], 1u);
    return b;
}
__device__ __forceinline__ void xcd_barrier_complete(unsigned* bar, unsigned x, unsigned& nloc, unsigned& nx) {
    const unsigned G = gridDim.x * gridDim.y * gridDim.z;
    unsigned sum, cnt, mine, sp = 0u;
    for (;;) {
        sum = 0u; cnt = 0u; mine = 0u;
#pragma unroll
        for (unsigned j = 0; j < 16; ++j) { const unsigned c = xb_ld(&bar[XB_XCNT(j)]); sum += c; cnt += (c > 0u) ? 1u : 0u; mine = (j == x) ? c : mine; }
        if (sum == G) break;
        __builtin_amdgcn_s_sleep(1);
        if ((++sp & 255u) == 0u) { if (xb_ld(&bar[XB_TMO])) break; if (sp > XB_SPIN_CAP) { atomicAdd(&bar[XB_TMO], 1u); break; } }
    }
    nloc = mine > 0u ? mine : 1u; nx = cnt > 0u ? cnt : 1u;
}
__device__ __forceinline__ void xcd_barrier(const XcdBarrier& b) {
    asm volatile("s_waitcnt vmcnt(0)" ::: "memory");
    __syncthreads();
    if (threadIdx.x == 0) {
        unsigned* bar = b.bar;
        __builtin_amdgcn_s_waitcnt(0);
        unsigned nloc = b.st[0], nx = b.st[1];
        if (nloc == 0u) { xcd_barrier_complete(bar, b.x, nloc, nx); b.st[0] = nloc; b.st[1] = nx; }
        const unsigned old = xb_add(&bar[XB_XSUB(b.x)], 1u);
        const unsigned gen = old / nloc;
        if (old + 1u == (gen + 1u) * nloc) {
            __builtin_amdgcn_fence(__ATOMIC_RELEASE, "agent");
            asm volatile("s_waitcnt vmcnt(0)" ::: "memory");
            const unsigned og = xb_add(&bar[XB_TOP], 1u);
            const unsigned tg = og / nx;
            if (og + 1u == (tg + 1u) * nx) xb_add(&bar[XB_TOPGEN], 1u);
            else XB_SPIN(xb_ld(&bar[XB_TOPGEN]) == tg, bar);
            __builtin_amdgcn_fence(__ATOMIC_ACQUIRE, "agent");
            xb_add(&bar[XB_XGEN(b.x)], 1u);
            asm volatile("s_waitcnt vmcnt(0)" ::: "memory");
        } else {
            XB_SPIN(xb_ld(&bar[XB_XGEN(b.x)]) == gen, bar);
            __builtin_amdgcn_fence(__ATOMIC_ACQUIRE, "agent");
            asm volatile("s_waitcnt vmcnt(0)" ::: "memory");
        }
    }
    __syncthreads();
}

struct Args { const float* in[33]; float* out; unsigned char* ws; int ph_lo, ph_hi; };
enum { I_X = 0, I_C, I_CTX, I_CCTX, I_WADA, I_BADA, I_N1G, I_N2G, I_WIN, I_CONVK, I_CONVB, I_GATEB, I_MLNG, I_MU, I_WUP, I_W0, I_AUP, I_A0, I_GUP, I_KK, I_KA, I_RK,
       I_LNW, I_LNB, I_PA, I_PB, I_WOUT, I_RTW, I_RTB, I_EG, I_EU, I_ED, I_FG };

__device__ __forceinline__ int row_mv(int r) { return r < RLAT ? (r >> 13) : 2; }

__device__ __forceinline__ void conv_item(const float* __restrict__ W, int K, int N, bf16_t* __restrict__ WT, int item, int lane) {
    const int nkb = K >> 6;
    const int nb = item / nkb, kb = item - nb * nkb;
    const int n = nb * 64 + lane, k0 = kb * 64;
    float v[64];
    if (n < N) {
        const float* p = W + (size_t)k0 * N + n;
#pragma unroll
        for (int i = 0; i < 64; ++i) v[i] = p[(size_t)i * N];
    } else {
#pragma unroll
        for (int i = 0; i < 64; ++i) v[i] = 0.f;
    }
    u32x4* o = (u32x4*)(WT + (size_t)n * K + k0);
#pragma unroll
    for (int i = 0; i < 8; ++i) { u32x4 w; w.x = pk2(v[8 * i], v[8 * i + 1]); w.y = pk2(v[8 * i + 2], v[8 * i + 3]); w.z = pk2(v[8 * i + 4], v[8 * i + 5]); w.w = pk2(v[8 * i + 6], v[8 * i + 7]); o[i] = w; }
}
constexpr int CONV_CORE_ITEMS = 1408 + 128 + 128 + 256 + 16 + 16 + 16;
__device__ __forceinline__ void conv_core(const Args& a, int l, int item, int lane) {
    unsigned char* ws = a.ws;
    if (item < 1408) { conv_item(a.in[I_WIN] + (size_t)l * D * IN_COLS, D, IN_COLS, (bf16_t*)(ws + WS_WIN), item, lane); return; } item -= 1408;
    if (item < 128) { conv_item(a.in[I_PA] + (size_t)l * 512 * D, 512, D, (bf16_t*)(ws + WS_WPA), item, lane); return; } item -= 128;
    if (item < 128) { conv_item(a.in[I_PB] + (size_t)l * 512 * D, 512, D, (bf16_t*)(ws + WS_WPB), item, lane); return; } item -= 128;
    if (item < 256) { conv_item(a.in[I_WOUT] + (size_t)l * D * D, D, D, (bf16_t*)(ws + WS_WOUT), item, lane); return; } item -= 256;
    if (item < 16) { const int d = item >> 3; conv_item(a.in[I_WUP] + (size_t)(l * 2 + d) * 64 * 512, 64, 512, (bf16_t*)(ws + WS_WUP) + d * 512 * 64, item & 7, lane); return; } item -= 16;
    if (item < 16) { const int d = item >> 3; conv_item(a.in[I_AUP] + (size_t)(l * 2 + d) * 64 * 512, 64, 512, (bf16_t*)(ws + WS_AUP) + d * 512 * 64, item & 7, lane); return; } item -= 16;
    conv_item(a.in[I_GUP] + (size_t)l * 128 * 512, 128, 512, (bf16_t*)(ws + WS_GUP), item, lane);
}
constexpr int CONV_EXP_ITEMS = 3 * 2048;
__device__ __forceinline__ void conv_exp(const Args& a, int l, int item, int lane) {
    unsigned char* ws = a.ws;
    const int which = item >> 11, it = item & 2047, e = it >> 7, sub = it & 127;
    if (which == 0) conv_item(a.in[I_EG] + ((size_t)l * NE + e) * D * DE, D, DE, (bf16_t*)(ws + A_WG) + (size_t)e * DE * D, sub, lane);
    else if (which == 1) conv_item(a.in[I_EU] + ((size_t)l * NE + e) * D * DE, D, DE, (bf16_t*)(ws + A_WU) + (size_t)e * DE * D, sub, lane);
    else conv_item(a.in[I_ED] + ((size_t)l * NE + e) * DE * D, DE, D, (bf16_t*)(ws + A_WD) + (size_t)e * D * DE, sub, lane);
}

__device__ __forceinline__ void phase_mod(const Args& a, LAS unsigned char* lds, int tid, int lane, int wave) {
    LAS float* sv = (LAS float*)lds;
    LAS float* part = sv + 3 * 1024;
    for (int i = tid; i < 3 * 1024; i += 512) {
        const int v = i >> 10, k = i & 1023;
        const float c = (v < 2) ? a.in[I_C][v * 1024 + k] : a.in[I_CCTX][k];
        sv[i] = siluf_(c);
    }
    __syncthreads();
    float* MOD = (float*)(a.ws + WS_MOD);
    for (int cb = blockIdx.x; cb < 256; cb += gridDim.x) {
        const int gc0 = cb * 48, l = gc0 / 6144, n0 = gc0 % 6144;
        float acc0 = 0.f, acc1 = 0.f, acc2 = 0.f;
        if (lane < 48) {
            const float* w = a.in[I_WADA] + (size_t)l * D * 6144 + n0 + lane;
            const int k0 = wave * 128;
#pragma unroll 8
            for (int k = 0; k < 128; ++k) { const float wv = w[(size_t)(k0 + k) * 6144]; acc0 += sv[k0 + k] * wv; acc1 += sv[1024 + k0 + k] * wv; acc2 += sv[2048 + k0 + k] * wv; }
            part[(wave * 3 + 0) * 48 + lane] = acc0; part[(wave * 3 + 1) * 48 + lane] = acc1; part[(wave * 3 + 2) * 48 + lane] = acc2;
        }
        __syncthreads();
        if (tid < 144) {
            const int v = tid / 48, j = tid % 48;
            float s = a.in[I_BADA][l * 6144 + n0 + j];
#pragma unroll
            for (int w8 = 0; w8 < 8; ++w8) s += part[(w8 * 3 + v) * 48 + j];
            MOD[((size_t)l * 3 + v) * 6144 + n0 + j] = s;
        }
        __syncthreads();
    }
}

__device__ __forceinline__ const float* xrow_in(const Args& a, int l, int r) {
    if (r < RLAT) return (l == 0 ? a.in[I_X] : (const float*)a.out) + (size_t)r * D;
    return (l == 0 ? a.in[I_CTX] : (const float*)(a.ws + WS_XCTX)) + (size_t)(r - RLAT) * D;
}
__device__ __forceinline__ float* xrow_out(const Args& a, int r) {
    if (r < RLAT) return a.out + (size_t)r * D;
    return (float*)(a.ws + WS_XCTX) + (size_t)(r - RLAT) * D;
}
__device__ __forceinline__ void norm_mod_row(const f32x4 (&v)[4], const float* __restrict__ g, const float* __restrict__ sh, const float* __restrict__ sc, bf16_t* __restrict__ orow, int lane, f32x4 (&hout)[4]) {
    float s = 0.f;
#pragma unroll
    for (int j = 0; j < 4; ++j) s += (v[j].x * v[j].x + v[j].y * v[j].y) + (v[j].z * v[j].z + v[j].w * v[j].w);
    s = wave_sum_shfl(s);
    const float rstd = rsqrtf(s * (1.0f / D) + NORM_EPS);
#pragma unroll
    for (int j = 0; j < 4; ++j) {
        const int idx = 4 * lane + 256 * j;
        const f32x4 gg = *(const f32x4*)(g + idx), s1 = *(const f32x4*)(sc + idx), s0 = *(const f32x4*)(sh + idx);
        f32x4 h;
        h.x = v[j].x * rstd * gg.x * (1.f + s1.x) + s0.x; h.y = v[j].y * rstd * gg.y * (1.f + s1.y) + s0.y;
        h.z = v[j].z * rstd * gg.z * (1.f + s1.z) + s0.z; h.w = v[j].w * rstd * gg.w * (1.f + s1.w) + s0.w;
        hout[j] = h;
        u32x2 o; o.x = pk2(h.x, h.y); o.y = pk2(h.z, h.w);
        *(u32x2*)(orow + idx) = o;
    }
}
__device__ __forceinline__ void phase_norm1(const Args& a, int l, int lane, int gw, int nw) {
    const float* MOD = (const float*)(a.ws + WS_MOD);
    bf16_t* H = (bf16_t*)(a.ws + A_H);
    for (int r = gw; r < RT; r += nw) {
        const float* xr = xrow_in(a, l, r);
        f32x4 v[4], h[4];
#pragma unroll
        for (int j = 0; j < 4; ++j) v[j] = *(const f32x4*)(xr + 4 * lane + 256 * j);
        const float* m = MOD + ((size_t)l * 3 + row_mv(r)) * 6144;
        norm_mod_row(v, a.in[I_N1G] + l * D, m, m + 1024, H + (size_t)r * D, lane, h);
    }
}

constexpr int G_LD = 72;
constexpr int G_OPER = 128 * G_LD;
__device__ __forceinline__ void gemm_tile(LAS bf16_t* sm, const bf16_t* pa0, const bf16_t* pa1, const bf16_t* pb0, const bf16_t* pb1, int nk,
                                          f32x4 (&acc)[4][2], int tid, int lane, int wm, int wn) {
    const int srow = tid >> 3, skc = tid & 7;
    const int so0 = srow * G_LD + skc * 8, so1 = (srow + 64) * G_LD + skc * 8;
    const int fr = lane & 15, fq = lane >> 4;
    u32x4 ra0 = *(const u32x4*)pa0, ra1 = *(const u32x4*)pa1, rb0 = *(const u32x4*)pb0, rb1 = *(const u32x4*)pb1;
    *(LAS u32x4*)(sm + so0) = ra0; *(LAS u32x4*)(sm + so1) = ra1; *(LAS u32x4*)(sm + G_OPER + so0) = rb0; *(LAS u32x4*)(sm + G_OPER + so1) = rb1;
    __syncthreads();
    for (int ks = 0; ks < nk; ++ks) {
        LAS bf16_t* A = sm + (ks & 1) * 2 * G_OPER;
        LAS bf16_t* B = A + G_OPER;
        const bool more = (ks + 1 < nk);
        if (more) { const int ko = (ks + 1) * 64; ra0 = *(const u32x4*)(pa0 + ko); ra1 = *(const u32x4*)(pa1 + ko); rb0 = *(const u32x4*)(pb0 + ko); rb1 = *(const u32x4*)(pb1 + ko); }
#pragma unroll
        for (int kk = 0; kk < 2; ++kk) {
            bf16x8 af[4], bfr[2];
#pragma unroll
            for (int mi = 0; mi < 4; ++mi) af[mi] = *(const LAS bf16x8*)(A + (wm * 64 + mi * 16 + fr) * G_LD + kk * 32 + fq * 8);
#pragma unroll
            for (int ni = 0; ni < 2; ++ni) bfr[ni] = *(const LAS bf16x8*)(B + (wn * 32 + ni * 16 + fr) * G_LD + kk * 32 + fq * 8);
#pragma unroll
            for (int mi = 0; mi < 4; ++mi)
#pragma unroll
                for (int ni = 0; ni < 2; ++ni) acc[mi][ni] = __builtin_amdgcn_mfma_f32_16x16x32_bf16(bfr[ni], af[mi], acc[mi][ni], 0, 0, 0);
        }
        if (more) {
            LAS bf16_t* A2 = sm + ((ks + 1) & 1) * 2 * G_OPER;
            *(LAS u32x4*)(A2 + so0) = ra0; *(LAS u32x4*)(A2 + so1) = ra1; *(LAS u32x4*)(A2 + G_OPER + so0) = rb0; *(LAS u32x4*)(A2 + G_OPER + so1) = rb1;
        }
        __syncthreads();
    }
}
#define ZERO_ACC(acc) do { _Pragma("unroll") for (int _i = 0; _i < 4; ++_i) _Pragma("unroll") for (int _j = 0; _j < 2; ++_j) acc[_i][_j] = (f32x4){0.f, 0.f, 0.f, 0.f}; } while (0)

__device__ __forceinline__ void phase_inproj(const Args& a, LAS unsigned char* lds, int tid, int lane, int wave) {
    LAS bf16_t* sm = (LAS bf16_t*)lds;
    const bf16_t* H = (const bf16_t*)(a.ws + A_H);
    const bf16_t* WT = (const bf16_t*)(a.ws + WS_WIN);
    bf16_t* PML = (bf16_t*)(a.ws + A_PML); bf16_t* PRW = (bf16_t*)(a.ws + A_PRW); bf16_t* PGT = (bf16_t*)(a.ws + A_PGT);
    const int wm = wave >> 2, wn = wave & 3, fr = lane & 15, fq = lane >> 4;
    const int srow = tid >> 3, skc = tid & 7;
    constexpr int NM = RT / 128, NN = IN_PAD / 128;
    for (int tile = blockIdx.x; tile < NM * NN; tile += gridDim.x) {
        const int tm = tile / NN, tn = tile - tm * NN;
        const bf16_t* pa0 = H + (size_t)(tm * 128 + srow) * D + skc * 8;
        const bf16_t* pa1 = pa0 + (size_t)64 * D;
        const bf16_t* pb0 = WT + (size_t)(tn * 128 + srow) * D + skc * 8;
        const bf16_t* pb1 = pb0 + (size_t)64 * D;
        f32x4 acc[4][2]; ZERO_ACC(acc);
        gemm_tile(sm, pa0, pa1, pb0, pb1, D / 64, acc, tid, lane, wm, wn);
#pragma unroll
        for (int mi = 0; mi < 4; ++mi) {
            const int row = tm * 128 + wm * 64 + mi * 16 + fr;
#pragma unroll
            for (int ni = 0; ni < 2; ++ni) {
                const int nc = tn * 128 + wn * 32 + ni * 16 + 4 * fq;
                u32x2 o; o.x = pk2(acc[mi][ni][0], acc[mi][ni][1]); o.y = pk2(acc[mi][ni][2], acc[mi][ni][3]);
                if (nc < ML_COLS) *(u32x2*)(PML + (size_t)row * ML_COLS + nc) = o;
                else if (nc < ML_COLS + RW_COLS) *(u32x2*)(PRW + (size_t)row * RW_COLS + (nc - ML_COLS)) = o;
                else if (nc < IN_COLS) *(u32x2*)(PGT + (size_t)row * GT_COLS + (nc - ML_COLS - RW_COLS)) = o;
            }
        }
    }
}

template <int KS> __device__ __forceinline__ f32x4 lds_mma(const LAS bf16_t* A, int lda, int m0, const LAS bf16_t* Bt, int ldb, int n0, f32x4 acc, int fr, int fq) {
#pragma unroll
    for (int ks = 0; ks < KS; ++ks) {
        const bf16x8 av = *(const LAS bf16x8*)(A + (m0 + fr) * lda + ks * 32 + fq * 8);
        const bf16x8 bv = *(const LAS bf16x8*)(Bt + (n0 + fr) * ldb + ks * 32 + fq * 8);
        acc = __builtin_amdgcn_mfma_f32_16x16x32_bf16(bv, av, acc, 0, 0, 0);
    }
    return acc;
}

__device__ __forceinline__ int chunk_row0(int b, int cc) { return cc < 4 ? RLAT + b * TC + cc * 64 : b * TL + (cc - 4) * 64; }
__device__ __forceinline__ void ml_gates(const Args& a, int l, int h, int row0, LAS float* gt, int lane) {
    const bf16_t* PML = (const bf16_t*)(a.ws + A_PML);
    const float* gb = a.in[I_GATEB] + l * 16;
    const bf16_t* p = PML + (size_t)(row0 + lane) * ML_COLS + 1536;
    float pre[4];
#pragma unroll
    for (int ty = 0; ty < 2; ++ty)
#pragma unroll
        for (int d = 0; d < 2; ++d) {
            const int ix = ty * 8 + d * 4 + h;
            const float x = bf2f(p[ix]) + gb[ix];
            pre[ty * 2 + d] = GATE_CAP * tanhf_(x * (1.0f / GATE_CAP));
        }
    float lff = -softplusf_(-pre[2]);
    float lfb = -softplusf_(-pre[3]);
    float cf = lff, cb = lfb;
#pragma unroll
    for (int o = 1; o < 64; o <<= 1) {
        const float uf = __shfl_up(cf, o), ub = __shfl_down(cb, o);
        if (lane >= o) cf += uf;
        if (lane + o < 64) cb += ub;
    }
    gt[lane] = cf; gt[64 + lane] = pre[0]; gt[128 + lane] = cb; gt[192 + lane] = pre[1];
}
__device__ __forceinline__ void ml_conv8(const Args& a, int l, int b, int cc, int t, int col, float (&o)[8]) {
    const bf16_t* PML = (const bf16_t*)(a.ws + A_PML);
    const float* taps = a.in[I_CONVK] + (size_t)l * 9 * 512;
    const float* bias = a.in[I_CONVB] + l * 512;
    { const f32x4 b0 = *(const f32x4*)(bias + col), b1 = *(const f32x4*)(bias + col + 4); o[0] = b0.x; o[1] = b0.y; o[2] = b0.z; o[3] = b0.w; o[4] = b1.x; o[5] = b1.y; o[6] = b1.z; o[7] = b1.w; }
#pragma unroll
    for (int dy = 0; dy < 3; ++dy)
#pragma unroll
        for (int dx = 0; dx < 3; ++dx) {
            int nr; bool ok;
            if (cc >= 4) { const int ny = (cc - 4) + dy - 1, nx = t + dx - 1; ok = (ny >= 0) && (ny < 128) && (nx >= 0) && (nx < 64); nr = b * TL + ny * 64 + nx; }
            else { const int nt = cc * 64 + t + dx - 1; ok = (dy == 1) && (nt >= 0) && (nt < TC); nr = RLAT + b * TC + nt; }
            if (ok) {
                float v[8]; unpack8(*(const u32x4*)(PML + (size_t)nr * ML_COLS + col), v);
                const float* tp = taps + (dy * 3 + dx) * 512 + col;
                const f32x4 t0 = *(const f32x4*)tp, t1 = *(const f32x4*)(tp + 4);
                o[0] += t0.x * v[0]; o[1] += t0.y * v[1]; o[2] += t0.z * v[2]; o[3] += t0.w * v[3];
                o[4] += t1.x * v[4]; o[5] += t1.y * v[5]; o[6] += t1.z * v[6]; o[7] += t1.w * v[7];
            }
        }
}
constexpr int ML_LD = 72;
__device__ __forceinline__ void ml_fill_vt(const Args& a, int h, int row0, LAS bf16_t* VT, int tid, int lane, int wave) {
    const bf16_t* PML = (const bf16_t*)(a.ws + A_PML);
#pragma unroll
    for (int i = 0; i < 2; ++i) {
        const int eg = wave * 2 + i;
        const u32x4 w = *(const u32x4*)(PML + (size_t)(row0 + lane) * ML_COLS + 512 + h * 128 + eg * 8);
        LAS bf16_t* d = VT + (eg * 8) * ML_LD + lane;
        d[0 * ML_LD] = (bf16_t)(w.x & 0xffffu); d[1 * ML_LD] = (bf16_t)(w.x >> 16); d[2 * ML_LD] = (bf16_t)(w.y & 0xffffu); d[3 * ML_LD] = (bf16_t)(w.y >> 16);
        d[4 * ML_LD] = (bf16_t)(w.z & 0xffffu); d[5 * ML_LD] = (bf16_t)(w.z >> 16); d[6 * ML_LD] = (bf16_t)(w.w & 0xffffu); d[7 * ML_LD] = (bf16_t)(w.w >> 16);
    }
    for (int i = tid; i < 16 * 64; i += 512) { const int rr = i >> 6, s = i & 63; VT[(128 + rr) * ML_LD + s] = (rr == 0) ? (bf16_t)0x3F80 : (bf16_t)0; }
}

__device__ __forceinline__ void phase_ml_a(const Args& a, int l, LAS unsigned char* lds, int tid, int lane, int wave) {
    LAS bf16_t* KTF = (LAS bf16_t*)lds;
    LAS bf16_t* KTB = KTF + 64 * ML_LD;
    LAS bf16_t* VT = KTB + 64 * ML_LD;
    LAS float* gt = (LAS float*)(VT + 144 * ML_LD);
    float* DC = (float*)(a.ws + A_DC); float* DN = (float*)(a.ws + A_DN); float* GG = (float*)(a.ws + A_G);
    const int fr = lane & 15, fq = lane >> 4;
    for (int item = blockIdx.x; item < NBATCH * ML_H * NCH; item += gridDim.x) {
        const int b = item / (ML_H * NCH), rem = item % (ML_H * NCH), h = rem / NCH, cc = rem % NCH;
        const int row0 = chunk_row0(b, cc);
        if (wave == 0) {
            ml_gates(a, l, h, row0, gt, lane);
            const float cf = gt[lane], cb = gt[128 + lane];
            const float cfl = __shfl(cf, 63), cb0 = __shfl(cb, 0);
            gt[256 + lane] = __expf(cfl - cf + gt[64 + lane]);
            gt[320 + lane] = __expf(cb0 - cb + gt[192 + lane]);
            if (lane == 0) {
                GG[((b * ML_H + h) * 2 + 0) * NCH + cc] = __expf(cfl);
                GG[((b * ML_H + h) * 2 + 1) * NCH + cc] = __expf(cb0);
            }
        }
        ml_fill_vt(a, h, row0, VT, tid, lane, wave);
        float kc[8];
        ml_conv8(a, l, b, cc, lane, 256 + h * 64 + wave * 8, kc);
        __syncthreads();
        {
            const float wf = gt[256 + lane] * 0.125f, wb = gt[320 + lane] * 0.125f;
#pragma unroll
            for (int j = 0; j < 8; ++j) { KTF[(wave * 8 + j) * ML_LD + lane] = (bf16_t)f2bf(kc[j] * wf); KTB[(wave * 8 + j) * ML_LD + lane] = (bf16_t)f2bf(kc[j] * wb); }
        }
        __syncthreads();
        for (int idx = wave; idx < 72; idx += 8) {
            const int dir = idx / 36, r2 = idx % 36, dt = r2 / 9, et = r2 % 9;
            f32x4 acc = {0.f, 0.f, 0.f, 0.f};
            acc = lds_mma<2>(dir ? KTB : KTF, ML_LD, dt * 16, VT, ML_LD, et * 16, acc, fr, fq);
            const size_t ci = (size_t)((b * ML_H + h) * 2 + dir) * NCH + cc;
            const int d = dt * 16 + fr;
            if (et < 8) *(f32x4*)(DC + ci * 8192 + d * 128 + et * 16 + 4 * fq) = acc;
            else if (fq == 0) DN[ci * 64 + d] = acc[0];
        }
        __syncthreads();
    }
}
__device__ __forceinline__ int ml_seq_cc(int dir, int i) { return dir ? (i < 4 ? 3 - i : 135 - i) : i; }
__device__ __forceinline__ void phase_ml_b(const Args& a, int tid) {
    float* DC = (float*)(a.ws + A_DC); float* DN = (float*)(a.ws + A_DN); const float* GG = (const float*)(a.ws + A_G);
    const int nthreads = gridDim.x * 512;
    for (int e = blockIdx.x * 512 + tid; e < 16 * 8192 + 16 * 64; e += nthreads) {
        int chain, elem, stride; float* base;
        if (e < 16 * 8192) { chain = e >> 13; elem = e & 8191; stride = 8192; base = DC + (size_t)chain * NCH * 8192 + elem; }
        else { const int e2 = e - 16 * 8192; chain = e2 >> 6; elem = e2 & 63; stride = 64; base = DN + (size_t)chain * NCH * 64 + elem; }
        const int dir = chain & 1;
        const float* g = GG + chain * NCH;
        float C = 0.f;
        for (int i0 = 0; i0 < NCH; i0 += 12) {
            float tv[12], gv[12];
#pragma unroll
            for (int j = 0; j < 12; ++j) { const int cc = ml_seq_cc(dir, i0 + j); tv[j] = base[(size_t)cc * stride]; gv[j] = g[cc]; }
#pragma unroll
            for (int j = 0; j < 12; ++j) { const int cc = ml_seq_cc(dir, i0 + j); base[(size_t)cc * stride] = C; C = gv[j] * C + tv[j]; }
        }
    }
}
__device__ __forceinline__ void phase_ml_c(const Args& a, int l, bool need_ctx, LAS unsigned char* lds, int tid, int lane, int wave) {
    LAS bf16_t* Q = (LAS bf16_t*)lds;
    LAS bf16_t* K = Q + 64 * ML_LD;
    LAS bf16_t* QF = K + 64 * ML_LD;
    LAS bf16_t* QB = QF + 64 * ML_LD;
    LAS bf16_t* SF = QB + 64 * ML_LD;
    LAS bf16_t* SB = SF + 64 * ML_LD;
    LAS bf16_t* VT = SB + 64 * ML_LD;
    LAS bf16_t* CF = VT + 144 * ML_LD;
    LAS bf16_t* CB = CF + 144 * ML_LD;
    LAS float* gt = (LAS float*)(CB + 144 * ML_LD);
    LAS float* red = gt + 256;
    const float* DC = (const float*)(a.ws + A_DC); const float* DN = (const float*)(a.ws + A_DN);
    const bf16_t* PML = (const bf16_t*)(a.ws + A_PML);
    bf16_t* AL = (bf16_t*)(a.ws + A_ALAT);
    const float* ng = a.in[I_MLNG] + l * 512;
    const int fr = lane & 15, fq = lane >> 4;
    for (int item = blockIdx.x; item < NBATCH * ML_H * NCH; item += gridDim.x) {
        const int b = item / (ML_H * NCH), rem = item % (ML_H * NCH), h = rem / NCH, cc = rem % NCH;
        if (cc < 4 && !need_ctx) continue;
        const int row0 = chunk_row0(b, cc);
        if (wave == 0) ml_gates(a, l, h, row0, gt, lane);
#pragma unroll
        for (int i = 0; i < 2; ++i) {
            const int g = tid + 512 * i, t = g >> 4, cg = g & 15;
            const int col = (cg < 8) ? (h * 64 + cg * 8) : (256 + h * 64 + (cg - 8) * 8);
            float o[8]; ml_conv8(a, l, b, cc, t, col, o);
            const float sc = (cg < 8) ? 1.0f : 0.125f;
            u32x4 w; w.x = pk2(o[0] * sc, o[1] * sc); w.y = pk2(o[2] * sc, o[3] * sc); w.z = pk2(o[4] * sc, o[5] * sc); w.w = pk2(o[6] * sc, o[7] * sc);
            *(LAS u32x4*)(((cg < 8) ? Q : K) + t * ML_LD + (cg & 7) * 8) = w;
        }
        ml_fill_vt(a, h, row0, VT, tid, lane, wave);
#pragma unroll
        for (int dir = 0; dir < 2; ++dir) {
            const size_t ci = (size_t)((b * ML_H + h) * 2 + dir) * NCH + cc;
            LAS bf16_t* CT = dir ? CB : CF;
            const float* src = DC + ci * 8192 + lane * 128 + wave * 16;
#pragma unroll
            for (int q4 = 0; q4 < 4; ++q4) {
                const f32x4 v = *(const f32x4*)(src + q4 * 4);
                LAS bf16_t* d = CT + (wave * 16 + q4 * 4) * ML_LD + lane;
                d[0] = (bf16_t)f2bf(v.x); d[ML_LD] = (bf16_t)f2bf(v.y); d[2 * ML_LD] = (bf16_t)f2bf(v.z); d[3 * ML_LD] = (bf16_t)f2bf(v.w);
            }
            for (int i = tid; i < 16 * 64; i += 512) { const int rr = i >> 6, dd = i & 63; CT[(128 + rr) * ML_LD + dd] = (rr == 0) ? (bf16_t)f2bf(DN[ci * 64 + dd]) : (bf16_t)0; }
        }
        __syncthreads();
        {
            const int tt = wave >> 1;
#pragma unroll
            for (int i = 0; i < 2; ++i) {
                const int st = (wave & 1) * 2 + i;
                f32x4 acc = {0.f, 0.f, 0.f, 0.f};
                acc = lds_mma<2>(Q, ML_LD, tt * 16, K, ML_LD, st * 16, acc, fr, fq);
                const int t = tt * 16 + fr, s0 = st * 16 + 4 * fq;
                const float bft = gt[t], bbt = gt[128 + t];
                float sf[4], sb[4];
#pragma unroll
                for (int r = 0; r < 4; ++r) {
                    const int s = s0 + r;
                    sf[r] = (s <= t) ? acc[r] * __expf(bft - gt[s] + gt[64 + s]) : 0.f;
                    sb[r] = (s >= t) ? acc[r] * __expf(bbt - gt[128 + s] + gt[192 + s]) : 0.f;
                }
                u32x2 w; w.x = pk2(sf[0], sf[1]); w.y = pk2(sf[2], sf[3]); *(LAS u32x2*)(SF + t * ML_LD + s0) = w;
                w.x = pk2(sb[0], sb[1]); w.y = pk2(sb[2], sb[3]); *(LAS u32x2*)(SB + t * ML_LD + s0) = w;
            }
            const int t = tid >> 3, dg = tid & 7;
            float qv[8]; unpack8(*(const LAS u32x4*)(Q + t * ML_LD + dg * 8), qv);
            const float ef = __expf(gt[t]), eb = __expf(gt[128 + t]);
            u32x4 w; w.x = pk2(qv[0] * ef, qv[1] * ef); w.y = pk2(qv[2] * ef, qv[3] * ef); w.z = pk2(qv[4] * ef, qv[5] * ef); w.w = pk2(qv[6] * ef, qv[7] * ef);
            *(LAS u32x4*)(QF + t * ML_LD + dg * 8) = w;
            w.x = pk2(qv[0] * eb, qv[1] * eb); w.y = pk2(qv[2] * eb, qv[3] * eb); w.z = pk2(qv[4] * eb, qv[5] * eb); w.w = pk2(qv[6] * eb, qv[7] * eb);
            *(LAS u32x4*)(QB + t * ML_LD + dg * 8) = w;
        }
        __syncthreads();
        const int tt = wave >> 1, eh = wave & 1;
        float hs[4][4];
        {
            f32x4 af[5], ab[5];
#pragma unroll
            for (int i = 0; i < 5; ++i) {
                const int et = (i < 4) ? (eh * 4 + i) : 8;
                f32x4 z = {0.f, 0.f, 0.f, 0.f};
                af[i] = lds_mma<2>(QF, ML_LD, tt * 16, CF, ML_LD, et * 16, z, fr, fq);
                af[i] = lds_mma<2>(SF, ML_LD, tt * 16, VT, ML_LD, et * 16, af[i], fr, fq);
                ab[i] = lds_mma<2>(QB, ML_LD, tt * 16, CB, ML_LD, et * 16, z, fr, fq);
                ab[i] = lds_mma<2>(SB, ML_LD, tt * 16, VT, ML_LD, et * 16, ab[i], fr, fq);
            }
            const float denf = __shfl(af[4][0], fr), denb = __shfl(ab[4][0], fr);
            const float rf = 1.0f / fmaxf(fabsf(denf), 1.0f), rb = 1.0f / fmaxf(fabsf(denb), 1.0f);
            float ss = 0.f;
#pragma unroll
            for (int i = 0; i < 4; ++i)
#pragma unroll
                for (int r = 0; r < 4; ++r) { const float v = af[i][r] * rf + ab[i][r] * rb; hs[i][r] = v; ss += v * v; }
            ss += __shfl_xor(ss, 16); ss += __shfl_xor(ss, 32);
            if (fq == 0) red[(tt * 16 + fr) * 2 + eh] = ss;
        }
        __syncthreads();
        {
            const int t = tt * 16 + fr;
            const float tot = red[t * 2] + red[t * 2 + 1];
            const float rinv = rsqrtf(tot * (1.0f / 128.0f) + NORM_EPS);
            const int row = row0 + t;
#pragma unroll
            for (int i = 0; i < 4; ++i) {
                const int col = h * 128 + (eh * 4 + i) * 16 + 4 * fq;
                float ov[4]; unpack4(*(const u32x2*)(PML + (size_t)row * ML_COLS + 1024 + col), ov);
                const f32x4 g4 = *(const f32x4*)(ng + col);
                u32x2 w;
                w.x = pk2(hs[i][0] * rinv * g4.x * sigmoidf_(ov[0]), hs[i][1] * rinv * g4.y * sigmoidf_(ov[1]));
                w.y = pk2(hs[i][2] * rinv * g4.z * sigmoidf_(ov[2]), hs[i][3] * rinv * g4.w * sigmoidf_(ov[3]));
                *(u32x2*)(AL + (size_t)row * 512 + col) = w;
            }
        }
        __syncthreads();
    }
}

__device__ __forceinline__ void rw_seq_bounds(int r, bool& hasp, bool& hasn) {
    int t, len;
    if (r < RLAT) { t = r & (TL - 1); len = TL; } else { t = (r - RLAT) & (TC - 1); len = TC; }
    hasp = t > 0; hasn = t < len - 1;
}
__device__ __forceinline__ void rw_shift8(const bf16_t* __restrict__ PRW, const float* __restrict__ mu, int r, bool hasp, bool hasn, int col, float (&o)[8]) {
    const bf16_t* p = PRW + (size_t)r * RW_COLS + col;
    float c[8], pv[8], nv[8];
    const float wp = hasp ? 0.5f : 0.f, wn = hasn ? 0.5f : 0.f;
    unpack8(*(const u32x4*)p, c);
    unpack8(*(const u32x4*)(p - (hasp ? RW_COLS : 0)), pv);
    unpack8(*(const u32x4*)(p + (hasn ? RW_COLS : 0)), nv);
    const f32x4 m0 = *(const f32x4*)(mu + col), m1 = *(const f32x4*)(mu + col + 4);
    const float m[8] = {m0.x, m0.y, m0.z, m0.w, m1.x, m1.y, m1.z, m1.w};
#pragma unroll
    for (int j = 0; j < 8; ++j) o[j] = c[j] + m[j] * (wp * pv[j] + wn * nv[j] - c[j]);
}
__device__ __forceinline__ void rw_shift4(const bf16_t* __restrict__ PRW, const float* __restrict__ mu, int r, bool hasp, bool hasn, int col, float (&o)[4]) {
    const bf16_t* p = PRW + (size_t)r * RW_COLS + col;
    float c[4], pv[4], nv[4];
    const float wp = hasp ? 0.5f : 0.f, wn = hasn ? 0.5f : 0.f;
    unpack4(*(const u32x2*)p, c);
    unpack4(*(const u32x2*)(p - (hasp ? RW_COLS : 0)), pv);
    unpack4(*(const u32x2*)(p + (hasn ? RW_COLS : 0)), nv);
    const f32x4 m0 = *(const f32x4*)(mu + col);
    const float m[4] = {m0.x, m0.y, m0.z, m0.w};
#pragma unroll
    for (int j = 0; j < 4; ++j) o[j] = c[j] + m[j] * (wp * pv[j] + wn * nv[j] - c[j]);
}
constexpr int RS_ = 9216;
#define RIMG(i) ((LAS bf16_t*)(lds + (i) * RS_))
__device__ __forceinline__ void st_row4(LAS bf16_t* img, int row, int col0, float a0, float a1, float a2, float a3) {
    u32x2 w; w.x = pk2(a0, a1); w.y = pk2(a2, a3); *(LAS u32x2*)(img + row * 72 + col0) = w;
}
__device__ __forceinline__ void st_tr4(LAS bf16_t* img, int row, int col0, float a0, float a1, float a2, float a3) {
    LAS bf16_t* d = img + col0 * 72 + row;
    d[0] = (bf16_t)f2bf(a0); d[72] = (bf16_t)f2bf(a1); d[144] = (bf16_t)f2bf(a2); d[216] = (bf16_t)f2bf(a3);
}
__device__ __forceinline__ int rw_item_row0(int b, int cc) { return chunk_row0(b, cc); }

__device__ __forceinline__ void phase_rw_a(const Args& a, int l, LAS unsigned char* lds, int tid, int lane, int wave) {
    const bf16_t* PRW = (const bf16_t*)(a.ws + A_PRW);
    const float* mu = a.in[I_MU] + l * RW_COLS;
    bf16_t* RG = (bf16_t*)(a.ws + A_RG); bf16_t* RYC = (bf16_t*)(a.ws + A_RYC); bf16_t* RYL = (bf16_t*)(a.ws + A_RYL);
    float* RH = (float*)(a.ws + A_RH); float* BON = (float*)(a.ws + A_BONUS);
    LAS float* LAM = (LAS float*)(lds + 13 * RS_);
    LAS float* SEG = (LAS float*)(lds + 13 * RS_ + 16384);
    LAS float* RED = SEG + 512;
    LAS float* LC = RED + 256;
    const int fr = lane & 15, fq = lane >> 4;
    const int mt = wave >> 1, ntb = (wave & 1) * 2;
    for (int item = blockIdx.x; item < RW_ITEMS; item += gridDim.x) {
        const int cc = item % NCH, chain = item / NCH, dir = chain & 1, hh = (chain >> 1) & 7, b = chain >> 4;
        const int row0 = rw_item_row0(b, cc);
        {
            const int tau = tid >> 3, g8 = tid & 7;
            const int row = row0 + (dir ? 63 - tau : tau);
            bool hasp, hasn; rw_seq_bounds(row, hasp, hasn);
            float v[8];
            rw_shift8(PRW, mu, row, hasp, hasn, 1536 + dir * 64 + g8 * 8, v);
            { u32x4 w; w.x = pk2(tanhf_(v[0]), tanhf_(v[1])); w.y = pk2(tanhf_(v[2]), tanhf_(v[3])); w.z = pk2(tanhf_(v[4]), tanhf_(v[5])); w.w = pk2(tanhf_(v[6]), tanhf_(v[7])); *(LAS u32x4*)(RIMG(0) + tau * 72 + g8 * 8) = w; }
            rw_shift8(PRW, mu, row, hasp, hasn, 1664 + dir * 64 + g8 * 8, v);
            { u32x4 w; w.x = pk2(v[0], v[1]); w.y = pk2(v[2], v[3]); w.z = pk2(v[4], v[5]); w.w = pk2(v[6], v[7]); *(LAS u32x4*)(RIMG(1) + tau * 72 + g8 * 8) = w; }
            rw_shift8(PRW, mu, row, hasp, hasn, hh * 64 + g8 * 8, v);
            { u32x4 w; w.x = pk2(v[0], v[1]); w.y = pk2(v[2], v[3]); w.z = pk2(v[4], v[5]); w.w = pk2(v[6], v[7]); *(LAS u32x4*)(RIMG(4) + tau * 72 + g8 * 8) = w; }
            rw_shift8(PRW, mu, row, hasp, hasn, 512 + hh * 64 + g8 * 8, v);
            { u32x4 w; w.x = pk2(v[0], v[1]); w.y = pk2(v[2], v[3]); w.z = pk2(v[4], v[5]); w.w = pk2(v[6], v[7]); *(LAS u32x4*)(RIMG(5) + tau * 72 + g8 * 8) = w; }
            rw_shift8(PRW, mu, row, hasp, hasn, 1024 + hh * 64 + g8 * 8, v);
            { LAS bf16_t* d = RIMG(9) + (g8 * 8) * 72 + tau;
#pragma unroll
              for (int j = 0; j < 8; ++j) d[j * 72] = (bf16_t)f2bf(v[j]); }
            const int n = tid >> 3;
            *(LAS u32x4*)(RIMG(2) + n * 72 + g8 * 8) = *(const u32x4*)((const bf16_t*)(a.ws + WS_WUP) + (size_t)(dir * 512 + hh * 64 + n) * 64 + g8 * 8);
            *(LAS u32x4*)(RIMG(3) + n * 72 + g8 * 8) = *(const u32x4*)((const bf16_t*)(a.ws + WS_AUP) + (size_t)(dir * 512 + hh * 64 + n) * 64 + g8 * 8);
        }
        __syncthreads();
        float dexp[2][4], av[2][4], kp[2][4], rp[2][4];
        const int tau = mt * 16 + fr;
        {
            float ss = 0.f;
#pragma unroll
            for (int i = 0; i < 2; ++i) {
                const int n0 = (ntb + i) * 16;
                f32x4 z = {0.f, 0.f, 0.f, 0.f};
                const f32x4 lw = lds_mma<2>(RIMG(0), 72, mt * 16, RIMG(2), 72, n0, z, fr, fq);
                const f32x4 aa = lds_mma<2>(RIMG(1), 72, mt * 16, RIMG(3), 72, n0, z, fr, fq);
                const int c = hh * 64 + n0 + 4 * fq;
                const f32x4 w04 = *(const f32x4*)(a.in[I_W0] + (l * 2 + dir) * 512 + c), a04 = *(const f32x4*)(a.in[I_A0] + (l * 2 + dir) * 512 + c);
                const f32x4 kk4 = *(const f32x4*)(a.in[I_KK] + l * 512 + c);
                float kv[4], rv[4];
                unpack4(*(const LAS u32x2*)(RIMG(5) + tau * 72 + n0 + 4 * fq), kv);
                unpack4(*(const LAS u32x2*)(RIMG(4) + tau * 72 + n0 + 4 * fq), rv);
#pragma unroll
                for (int r = 0; r < 4; ++r) {
                    const float lwv = w04[r] + lw[r];
                    dexp[i][r] = __expf(-softplusf_(-lwv) - 0.5f);
                    av[i][r] = sigmoidf_(a04[r] + aa[r]);
                    kp[i][r] = kv[r]; rp[i][r] = rv[r];
                    const float q = kv[r] * kk4[r]; ss += q * q;
                }
                *(LAS f32x4*)(LAM + tau * 64 + n0 + 4 * fq) = (f32x4){dexp[i][0], dexp[i][1], dexp[i][2], dexp[i][3]};
            }
            ss += __shfl_xor(ss, 16); ss += __shfl_xor(ss, 32);
            if (fq == 0) RED[tau * 2 + (wave & 1)] = ss;
        }
        __syncthreads();
        {
            const int n = tid & 63, seg = tid >> 6;
            float s = 0.f;
#pragma unroll
            for (int t = 0; t < 8; ++t) s += LAM[(seg * 8 + t) * 64 + n];
            SEG[seg * 64 + n] = s;
        }
        __syncthreads();
        {
            const int n = tid & 63, seg = tid >> 6;
            float run = 0.f;
#pragma unroll
            for (int s8 = 0; s8 < 8; ++s8) if (s8 < seg) run += SEG[s8 * 64 + n];
#pragma unroll
            for (int t = 0; t < 8; ++t) { run += LAM[(seg * 8 + t) * 64 + n]; LAM[(seg * 8 + t) * 64 + n] = -run; }
        }
        __syncthreads();
        {
            const float kn = rsqrtf(RED[tau * 2] + RED[tau * 2 + 1] + 1e-12f);
            float bon = 0.f;
#pragma unroll
            for (int i = 0; i < 2; ++i) {
                const int n0 = (ntb + i) * 16 + 4 * fq;
                const int c = hh * 64 + n0;
                const f32x4 lam4 = *(const LAS f32x4*)(LAM + tau * 64 + n0), lamc4 = *(const LAS f32x4*)(LAM + 63 * 64 + n0);
                const f32x4 kk4 = *(const f32x4*)(a.in[I_KK] + l * 512 + c), ka4 = *(const f32x4*)(a.in[I_KA] + l * 512 + c), rk4 = *(const f32x4*)(a.in[I_RK] + l * 512 + c);
                float kq[4], qt[4], kh[4], bh[4], kb[4], bb[4];
#pragma unroll
                for (int r = 0; r < 4; ++r) {
                    const float lam = lam4[r];
                    const float Lm = __expf(lam), Li = __expf(-lam), Lp = __expf(lam + dexp[i][r]), Lc = __expf(lamc4[r]);
                    const float kkv = kp[i][r] * kk4[r] * kn;
                    const float beta = kkv * av[i][r];
                    const float kd = kp[i][r] * (1.0f + (av[i][r] - 1.0f) * ka4[r]);
                    bon += rp[i][r] * kd * rk4[r];
                    kq[r] = kkv * Lp; qt[r] = rp[i][r] * Lm; kh[r] = kd * Li; bh[r] = beta * Li; kb[r] = kh[r] * Lc; bb[r] = bh[r] * Lc;
                }
                st_row4(RIMG(0), tau, n0, kq[0], kq[1], kq[2], kq[3]);
                st_row4(RIMG(1), tau, n0, qt[0], qt[1], qt[2], qt[3]);
                st_row4(RIMG(2), tau, n0, kh[0], kh[1], kh[2], kh[3]);
                st_row4(RIMG(3), tau, n0, bh[0], bh[1], bh[2], bh[3]);
                st_tr4(RIMG(6), tau, n0, kq[0], kq[1], kq[2], kq[3]);
                st_tr4(RIMG(7), tau, n0, kb[0], kb[1], kb[2], kb[3]);
                st_tr4(RIMG(8), tau, n0, bb[0], bb[1], bb[2], bb[3]);
            }
            bon += __shfl_xor(bon, 16); bon += __shfl_xor(bon, 32);
            if (fq == 0) RED[128 + tau * 2 + (wave & 1)] = bon;
            if (tid < 64) LC[tid] = __expf(LAM[63 * 64 + tid]);
        }
        __syncthreads();
        if (tid < 64) {
            const int row = row0 + (dir ? 63 - tid : tid);
            BON[((size_t)dir * RT + row) * 8 + hh] = RED[128 + tid * 2] + RED[128 + tid * 2 + 1];
        }
        f32x4 areg[2];
#pragma unroll
        for (int i = 0; i < 2; ++i) {
            const int s0 = (ntb + i) * 16;
            f32x4 z = {0.f, 0.f, 0.f, 0.f};
            const f32x4 akk = lds_mma<2>(RIMG(0), 72, mt * 16, RIMG(2), 72, s0, z, fr, fq);
            const f32x4 lll = lds_mma<2>(RIMG(0), 72, mt * 16, RIMG(3), 72, s0, z, fr, fq);
            const f32x4 akr = lds_mma<2>(RIMG(1), 72, mt * 16, RIMG(2), 72, s0, z, fr, fq);
            const f32x4 abr = lds_mma<2>(RIMG(1), 72, mt * 16, RIMG(3), 72, s0, z, fr, fq);
            const int sc = s0 + 4 * fq;
            float m1[4], m2[4], m3[4], m4[4], a0v[4];
#pragma unroll
            for (int r = 0; r < 4; ++r) {
                const int s = sc + r;
                m1[r] = (s < tau) ? akk[r] : 0.f; m2[r] = (s < tau) ? -lll[r] : 0.f;
                m3[r] = (s <= tau) ? akr[r] : 0.f; m4[r] = (s <= tau) ? abr[r] : 0.f;
                a0v[r] = m2[r] + ((s == tau) ? 1.0f : 0.f);
            }
            st_row4(RIMG(4), tau, sc, m1[0], m1[1], m1[2], m1[3]);
            st_row4(RIMG(5), tau, sc, m3[0], m3[1], m3[2], m3[3]);
            st_row4(RIMG(10), tau, sc, m4[0], m4[1], m4[2], m4[3]);
            st_row4(RIMG(11), tau, sc, m2[0], m2[1], m2[2], m2[3]);
            st_tr4(RIMG(12), tau, sc, m2[0], m2[1], m2[2], m2[3]);
            st_row4(RIMG(13), tau, sc, a0v[0], a0v[1], a0v[2], a0v[3]);
            areg[i] = (f32x4){a0v[0], a0v[1], a0v[2], a0v[3]};
        }
        __syncthreads();
#pragma unroll
        for (int rnd = 1; rnd <= 6; ++rnd) {
            const int pin = (rnd & 1) ? 11 : 0, pint = (rnd & 1) ? 12 : 2, pout = (rnd & 1) ? 0 : 11, poutt = (rnd & 1) ? 2 : 12;
            const int ain = (rnd & 1) ? 3 : 13, aout = (rnd & 1) ? 13 : 3;
#pragma unroll
            for (int i = 0; i < 2; ++i) {
                const int s0 = (ntb + i) * 16, sc = s0 + 4 * fq;
                f32x4 z = {0.f, 0.f, 0.f, 0.f};
                if (rnd <= 5) {
                    const f32x4 pp = lds_mma<2>(RIMG(pin), 72, mt * 16, RIMG(pint), 72, s0, z, fr, fq);
                    if (rnd < 5) st_row4(RIMG(pout), tau, sc, pp[0], pp[1], pp[2], pp[3]);
                    st_tr4(RIMG(poutt), tau, sc, pp[0], pp[1], pp[2], pp[3]);
                }
                if (rnd >= 2) {
                    const f32x4 ap = lds_mma<2>(RIMG(ain), 72, mt * 16, RIMG(pint), 72, s0, z, fr, fq);
                    areg[i] += ap;
                    st_row4(RIMG(aout), tau, sc, areg[i][0], areg[i][1], areg[i][2], areg[i][3]);
                }
            }
            __syncthreads();
        }
#pragma unroll
        for (int i = 0; i < 2; ++i) {
            const int n0 = (ntb + i) * 16, nc = n0 + 4 * fq;
            f32x4 z = {0.f, 0.f, 0.f, 0.f};
            const f32x4 pp = lds_mma<2>(RIMG(3), 72, mt * 16, RIMG(6), 72, n0, z, fr, fq);
            const f32x4 m1 = lds_mma<2>(RIMG(4), 72, mt * 16, RIMG(9), 72, n0, z, fr, fq);
            st_tr4(RIMG(11), tau, nc, pp[0], pp[1], pp[2], pp[3]);
            st_tr4(RIMG(12), tau, nc, m1[0], m1[1], m1[2], m1[3]);
        }
        __syncthreads();
#pragma unroll
        for (int i = 0; i < 2; ++i) {
            const int n0 = (ntb + i) * 16, nc = n0 + 4 * fq;
            f32x4 z = {0.f, 0.f, 0.f, 0.f};
            const f32x4 ww = lds_mma<2>(RIMG(3), 72, mt * 16, RIMG(12), 72, n0, z, fr, fq);
            st_tr4(RIMG(0), tau, nc, ww[0], ww[1], ww[2], ww[3]);
        }
        __syncthreads();
        {
            bf16_t* Gp = RG + (size_t)item * 4096; float* Ht = RH + (size_t)item * 4096;
            bf16_t* Yc = RYC + (size_t)item * 4096; bf16_t* Yl = RYL + (size_t)item * 4096;
            const int irow = mt * 16 + fr;
#pragma unroll
            for (int i = 0; i < 2; ++i) {
                const int n0 = (ntb + i) * 16, nc = n0 + 4 * fq;
                f32x4 z = {0.f, 0.f, 0.f, 0.f};
                const f32x4 gbp = lds_mma<2>(RIMG(8), 72, mt * 16, RIMG(11), 72, n0, z, fr, fq);
                f32x4 hh1 = lds_mma<2>(RIMG(7), 72, mt * 16, RIMG(9), 72, n0, z, fr, fq);
                const f32x4 hh2 = lds_mma<2>(RIMG(8), 72, mt * 16, RIMG(0), 72, n0, z, fr, fq);
                const f32x4 ycp = lds_mma<2>(RIMG(10), 72, mt * 16, RIMG(11), 72, n0, z, fr, fq);
                f32x4 yl1 = lds_mma<2>(RIMG(5), 72, mt * 16, RIMG(9), 72, n0, z, fr, fq);
                const f32x4 yl2 = lds_mma<2>(RIMG(10), 72, mt * 16, RIMG(0), 72, n0, z, fr, fq);
                const float lci = LC[irow];
                float g[4];
#pragma unroll
                for (int r = 0; r < 4; ++r) g[r] = ((nc + r == irow) ? lci : 0.f) - gbp[r];
                {
                    const int c = nc, ks = c >> 5, jhi = (c >> 4) & 1, fq2 = (c >> 2) & 3;
                    u32x2 w; w.x = pk2(g[0], g[1]); w.y = pk2(g[2], g[3]);
                    *(u32x2*)(Gp + (((irow >> 4) * 2 + ks) * 16 + (irow & 15)) * 32 + fq2 * 8 + jhi * 4) = w;
                }
#pragma unroll
                for (int r = 0; r < 4; ++r) Ht[(nc + r) * 64 + irow] = hh1[r] - hh2[r];
                float qv[4]; unpack4(*(const LAS u32x2*)(RIMG(1) + irow * 72 + nc), qv);
                { u32x2 w; w.x = pk2(qv[0] - ycp[0], qv[1] - ycp[1]); w.y = pk2(qv[2] - ycp[2], qv[3] - ycp[3]); *(u32x2*)(Yc + irow * 64 + nc) = w; }
                { u32x2 w; w.x = pk2(yl1[0] - yl2[0], yl1[1] - yl2[1]); w.y = pk2(yl1[2] - yl2[2], yl1[3] - yl2[3]); *(u32x2*)(Yl + irow * 64 + nc) = w; }
            }
        }
        __syncthreads();
    }
}
__device__ __forceinline__ void phase_rw_b(const Args& a, int lane, int gwave) {
    if (gwave >= 128) return;
    const int chain = gwave >> 2, j0 = (gwave & 3) * 16;
    const int dir = chain & 1;
    const int fr = lane & 15, fq = lane >> 4;
    const bf16_t* RG = (const bf16_t*)(a.ws + A_RG); float* RH = (float*)(a.ws + A_RH);
    f32x4 acc[4];
#pragma unroll
    for (int mi = 0; mi < 4; ++mi) acc[mi] = (f32x4){0.f, 0.f, 0.f, 0.f};
    bf16x8 gf[4][2]; f32x4 hv[4];
    {
        const size_t item = (size_t)chain * NCH + ml_seq_cc(dir, 0);
#pragma unroll
        for (int mi = 0; mi < 4; ++mi) {
#pragma unroll
            for (int ks = 0; ks < 2; ++ks) gf[mi][ks] = *(const bf16x8*)(RG + item * 4096 + ((mi * 2 + ks) * 16 + fr) * 32 + fq * 8);
            hv[mi] = *(const f32x4*)(RH + item * 4096 + (j0 + fr) * 64 + 16 * mi + 4 * fq);
        }
    }
    for (int i = 0; i < NCH; ++i) {
        const size_t item = (size_t)chain * NCH + ml_seq_cc(dir, i);
        u32x4 zb[2];
#pragma unroll
        for (int ks = 0; ks < 2; ++ks) {
            zb[ks].x = pk2(acc[2 * ks][0], acc[2 * ks][1]); zb[ks].y = pk2(acc[2 * ks][2], acc[2 * ks][3]);
            zb[ks].z = pk2(acc[2 * ks + 1][0], acc[2 * ks + 1][1]); zb[ks].w = pk2(acc[2 * ks + 1][2], acc[2 * ks + 1][3]);
        }
        f32x4 nacc[4];
#pragma unroll
        for (int mi = 0; mi < 4; ++mi) {
            nacc[mi] = hv[mi];
#pragma unroll
            for (int ks = 0; ks < 2; ++ks) nacc[mi] = __builtin_amdgcn_mfma_f32_16x16x32_bf16(gf[mi][ks], __builtin_bit_cast(bf16x8, zb[ks]), nacc[mi], 0, 0, 0);
        }
        asm volatile("" : "+v"(nacc[0]), "+v"(nacc[1]), "+v"(nacc[2]), "+v"(nacc[3]));
        {
            bf16_t* zt = (bf16_t*)(RH + item * 4096) + (j0 + fr) * 128 + 4 * fq;
#pragma unroll
            for (int ks = 0; ks < 2; ++ks) {
                u32x2 lo; lo.x = zb[ks].x; lo.y = zb[ks].y; u32x2 hi; hi.x = zb[ks].z; hi.y = zb[ks].w;
                *(u32x2*)(zt + 16 * (2 * ks)) = lo; *(u32x2*)(zt + 16 * (2 * ks + 1)) = hi;
            }
        }
        if (i + 1 < NCH) {
            const size_t nitem = (size_t)chain * NCH + ml_seq_cc(dir, i + 1);
#pragma unroll
            for (int mi = 0; mi < 4; ++mi) {
#pragma unroll
                for (int ks = 0; ks < 2; ++ks) gf[mi][ks] = *(const bf16x8*)(RG + nitem * 4096 + ((mi * 2 + ks) * 16 + fr) * 32 + fq * 8);
                hv[mi] = *(const f32x4*)(RH + nitem * 4096 + (j0 + fr) * 64 + 16 * mi + 4 * fq);
            }
        }
#pragma unroll
        for (int mi = 0; mi < 4; ++mi) acc[mi] = nacc[mi];
    }
}
__device__ __forceinline__ void phase_rw_c(const Args& a, int l, bool need_ctx, LAS unsigned char* lds, int tid, int lane, int wave) {
    const bf16_t* PRW = (const bf16_t*)(a.ws + A_PRW);
    const float* mu = a.in[I_MU] + l * RW_COLS;
    const bf16_t* RYC = (const bf16_t*)(a.ws + A_RYC); const bf16_t* RYL = (const bf16_t*)(a.ws + A_RYL);
    const float* RH = (const float*)(a.ws + A_RH); const float* BON = (const float*)(a.ws + A_BONUS);
    bf16_t* BL = (bf16_t*)(a.ws + A_BLAT);
    LAS bf16_t* SG = (LAS bf16_t*)(lds + 4 * RS_);
    LAS bf16_t* GU = (LAS bf16_t*)(lds + 4 * RS_ + 17408);
    LAS float* YS = (LAS float*)(lds + 4 * RS_ + 2 * 17408);
    LAS float* GS = YS + 2 * 64 * 68;
    const int fr = lane & 15, fq = lane >> 4;
    const int mt = wave >> 1, ntb = (wave & 1) * 2;
    for (int item = blockIdx.x; item < 16 * NCH; item += gridDim.x) {
        const int cc = item % NCH, bh = item / NCH, hh = bh & 7, b = bh >> 3;
        if (cc < 4 && !need_ctx) continue;
        const int row0 = rw_item_row0(b, cc);
        {
            const int t = tid >> 3, g8 = tid & 7;
#pragma unroll
            for (int dir = 0; dir < 2; ++dir) {
                const size_t it = (size_t)((b * 8 + hh) * 2 + dir) * NCH + cc;
                *(LAS u32x4*)(RIMG(dir) + t * 72 + g8 * 8) = *(const u32x4*)(RYC + it * 4096 + t * 64 + g8 * 8);
                *(LAS u32x4*)(RIMG(2 + dir) + t * 72 + g8 * 8) = *(const u32x4*)((const bf16_t*)(RH + it * 4096) + t * 128 + g8 * 8);
            }
            const int row = row0 + t;
            bool hasp, hasn; rw_seq_bounds(row, hasp, hasn);
#pragma unroll
            for (int hf = 0; hf < 2; ++hf) {
                float v[8]; rw_shift8(PRW, mu, row, hasp, hasn, 1792 + hf * 64 + g8 * 8, v);
                u32x4 w; w.x = pk2(sigmoidf_(v[0]), sigmoidf_(v[1])); w.y = pk2(sigmoidf_(v[2]), sigmoidf_(v[3])); w.z = pk2(sigmoidf_(v[4]), sigmoidf_(v[5])); w.w = pk2(sigmoidf_(v[6]), sigmoidf_(v[7]));
                *(LAS u32x4*)(SG + t * 136 + hf * 64 + g8 * 8) = w;
                *(LAS u32x4*)(GU + t * 136 + hf * 64 + g8 * 8) = *(const u32x4*)((const bf16_t*)(a.ws + WS_GUP) + (size_t)(hh * 64 + t) * 128 + hf * 64 + g8 * 8);
            }
        }
        __syncthreads();
        {
            const int tau = mt * 16 + fr;
#pragma unroll
            for (int dir = 0; dir < 2; ++dir) {
                const size_t it = (size_t)((b * 8 + hh) * 2 + dir) * NCH + cc;
                const int t = dir ? 63 - tau : tau;
#pragma unroll
                for (int i = 0; i < 2; ++i) {
                    const int n0 = (ntb + i) * 16, nc = n0 + 4 * fq;
                    float yl[4]; unpack4(*(const u32x2*)(RYL + it * 4096 + tau * 64 + nc), yl);
                    f32x4 acc = {yl[0], yl[1], yl[2], yl[3]};
                    acc = lds_mma<2>(RIMG(dir), 72, mt * 16, RIMG(2 + dir), 72, n0, acc, fr, fq);
                    *(LAS f32x4*)(YS + (dir * 64 + t) * 68 + nc) = acc;
                }
            }
#pragma unroll
            for (int i = 0; i < 2; ++i) {
                const int n0 = (ntb + i) * 16, nc = n0 + 4 * fq;
                f32x4 z = {0.f, 0.f, 0.f, 0.f};
                const f32x4 g = lds_mma<4>(SG, 136, mt * 16, GU, 136, n0, z, fr, fq);
                *(LAS f32x4*)(GS + tau * 68 + nc) = g;
            }
        }
        __syncthreads();
        {
            const int t = tid >> 3, g8 = tid & 7;
            const int row = row0 + t;
            float y[8]; float s = 0.f;
            { const f32x4 a0 = *(const LAS f32x4*)(YS + t * 68 + g8 * 8), a1 = *(const LAS f32x4*)(YS + t * 68 + g8 * 8 + 4);
              const f32x4 b0 = *(const LAS f32x4*)(YS + (64 + t) * 68 + g8 * 8), b1 = *(const LAS f32x4*)(YS + (64 + t) * 68 + g8 * 8 + 4);
              y[0] = a0[0] + b0[0]; y[1] = a0[1] + b0[1]; y[2] = a0[2] + b0[2]; y[3] = a0[3] + b0[3]; y[4] = a1[0] + b1[0]; y[5] = a1[1] + b1[1]; y[6] = a1[2] + b1[2]; y[7] = a1[3] + b1[3]; }
#pragma unroll
            for (int j = 0; j < 8; ++j) s += y[j];
            s += __shfl_xor(s, 1); s += __shfl_xor(s, 2); s += __shfl_xor(s, 4);
            const float mean = s * (1.0f / 64.0f);
            float q = 0.f;
#pragma unroll
            for (int j = 0; j < 8; ++j) { const float d = y[j] - mean; q += d * d; }
            q += __shfl_xor(q, 1); q += __shfl_xor(q, 2); q += __shfl_xor(q, 4);
            const float rstd = rsqrtf(q * (1.0f / 64.0f) + RW_GN_EPS);
            bool hasp, hasn; rw_seq_bounds(row, hasp, hasn);
            float vv[8]; rw_shift8(PRW, mu, row, hasp, hasn, 1024 + hh * 64 + g8 * 8, vv);
            const float bon = BON[((size_t)0 * RT + row) * 8 + hh] + BON[((size_t)1 * RT + row) * 8 + hh];
            const float* lnw = a.in[I_LNW] + l * 512 + hh * 64 + g8 * 8; const float* lnb = a.in[I_LNB] + l * 512 + hh * 64 + g8 * 8;
            const f32x4 w0 = *(const f32x4*)lnw, w1 = *(const f32x4*)(lnw + 4), b0 = *(const f32x4*)lnb, b1 = *(const f32x4*)(lnb + 4);
            const float lw[8] = {w0.x, w0.y, w0.z, w0.w, w1.x, w1.y, w1.z, w1.w}, lb[8] = {b0.x, b0.y, b0.z, b0.w, b1.x, b1.y, b1.z, b1.w};
            const f32x4 g0 = *(const LAS f32x4*)(GS + t * 68 + g8 * 8), g1 = *(const LAS f32x4*)(GS + t * 68 + g8 * 8 + 4);
            const float gg[8] = {g0[0], g0[1], g0[2], g0[3], g1[0], g1[1], g1[2], g1[3]};
            float ov[8];
#pragma unroll
            for (int j = 0; j < 8; ++j) ov[j] = ((y[j] - mean) * rstd * lw[j] + lb[j] + bon * vv[j]) * gg[j];
            u32x4 w; w.x = pk2(ov[0], ov[1]); w.y = pk2(ov[2], ov[3]); w.z = pk2(ov[4], ov[5]); w.w = pk2(ov[6], ov[7]);
            *(u32x4*)(BL + (size_t)row * 512 + hh * 64 + g8 * 8) = w;
        }
        __syncthreads();
    }
}

__device__ __forceinline__ void phase_merge1(const Args& a, bool need_ctx, LAS unsigned char* lds, int tid, int lane, int wave) {
    LAS bf16_t* sm = (LAS bf16_t*)lds;
    const bf16_t* AL = (const bf16_t*)(a.ws + A_ALAT); const bf16_t* BL = (const bf16_t*)(a.ws + A_BLAT);
    const bf16_t* WPA = (const bf16_t*)(a.ws + WS_WPA); const bf16_t* WPB = (const bf16_t*)(a.ws + WS_WPB);
    const bf16_t* PGT = (const bf16_t*)(a.ws + A_PGT);
    bf16_t* U = (bf16_t*)(a.ws + A_U);
    const int wm = wave >> 2, wn = wave & 3, fr = lane & 15, fq = lane >> 4;
    const int srow = tid >> 3, skc = tid & 7;
    const int NM = (need_ctx ? RT : RLAT) / 128;
    for (int tile = blockIdx.x; tile < NM * 8; tile += gridDim.x) {
        const int tm = tile >> 3, tn = tile & 7;
        f32x4 acc[4][2], acc2[4][2]; ZERO_ACC(acc); ZERO_ACC(acc2);
        {
            const bf16_t* pa0 = AL + (size_t)(tm * 128 + srow) * 512 + skc * 8;
            const bf16_t* pb0 = WPA + (size_t)(tn * 128 + srow) * 512 + skc * 8;
            gemm_tile(sm, pa0, pa0 + (size_t)64 * 512, pb0, pb0 + (size_t)64 * 512, 8, acc, tid, lane, wm, wn);
        }
        {
            const bf16_t* pa0 = BL + (size_t)(tm * 128 + srow) * 512 + skc * 8;
            const bf16_t* pb0 = WPB + (size_t)(tn * 128 + srow) * 512 + skc * 8;
            gemm_tile(sm, pa0, pa0 + (size_t)64 * 512, pb0, pb0 + (size_t)64 * 512, 8, acc2, tid, lane, wm, wn);
        }
#pragma unroll
        for (int mi = 0; mi < 4; ++mi) {
            const int row = tm * 128 + wm * 64 + mi * 16 + fr;
#pragma unroll
            for (int ni = 0; ni < 2; ++ni) {
                const int nc = tn * 128 + wn * 32 + ni * 16 + 4 * fq;
                float ga[4], gb[4];
                unpack4(*(const u32x2*)(PGT + (size_t)row * GT_COLS + nc), ga);
                unpack4(*(const u32x2*)(PGT + (size_t)row * GT_COLS + 1024 + nc), gb);
                float o[4];
#pragma unroll
                for (int j = 0; j < 4; ++j) o[j] = sigmoidf_(ga[j]) * acc[mi][ni][j] + sigmoidf_(gb[j]) * acc2[mi][ni][j];
                u32x2 w; w.x = pk2(o[0], o[1]); w.y = pk2(o[2], o[3]);
                *(u32x2*)(U + (size_t)row * D + nc) = w;
            }
        }
    }
}
__device__ __forceinline__ void phase_merge2(const Args& a, int l, bool need_ctx, LAS unsigned char* lds, int tid, int lane, int wave) {
    LAS bf16_t* sm = (LAS bf16_t*)lds;
    const bf16_t* U = (const bf16_t*)(a.ws + A_U); const bf16_t* WO = (const bf16_t*)(a.ws + WS_WOUT);
    const float* MOD = (const float*)(a.ws + WS_MOD);
    const int wm = wave >> 2, wn = wave & 3, fr = lane & 15, fq = lane >> 4;
    const int srow = tid >> 3, skc = tid & 7;
    const int NM = (need_ctx ? RT : RLAT) / 128;
    for (int tile = blockIdx.x; tile < NM * 8; tile += gridDim.x) {
        const int tm = tile >> 3, tn = tile & 7;
        f32x4 acc[4][2]; ZERO_ACC(acc);
        const bf16_t* pa0 = U + (size_t)(tm * 128 + srow) * D + skc * 8;
        const bf16_t* pb0 = WO + (size_t)(tn * 128 + srow) * D + skc * 8;
        gemm_tile(sm, pa0, pa0 + (size_t)64 * D, pb0, pb0 + (size_t)64 * D, 16, acc, tid, lane, wm, wn);
#pragma unroll
        for (int mi = 0; mi < 4; ++mi) {
            const int row = tm * 128 + wm * 64 + mi * 16 + fr;
            const float* g1 = MOD + ((size_t)l * 3 + row_mv(row)) * 6144 + 2048;
            const float* xi = xrow_in(a, l, row); float* xo = xrow_out(a, row);
#pragma unroll
            for (int ni = 0; ni < 2; ++ni) {
                const int nc = tn * 128 + wn * 32 + ni * 16 + 4 * fq;
                const f32x4 g = *(const f32x4*)(g1 + nc), x = *(const f32x4*)(xi + nc);
                f32x4 o; o.x = x.x + g.x * acc[mi][ni][0]; o.y = x.y + g.y * acc[mi][ni][1]; o.z = x.z + g.z * acc[mi][ni][2]; o.w = x.w + g.w * acc[mi][ni][3];
                *(f32x4*)(xo + nc) = o;
            }
        }
    }
}

__device__ __forceinline__ void phase_router(const Args& a, int l, bool need_ctx, LAS unsigned char* lds, int tid, int lane, int wave) {
    LAS float* Wt = (LAS float*)lds;
    LAS int* se = (LAS int*)(lds + 65536);
    for (int i = tid; i < 16 * 1024; i += 512) { const int k = i >> 4, e = i & 15; Wt[e * 1024 + k] = a.in[I_RTW][i]; }
    __syncthreads();
    const float* MOD = (const float*)(a.ws + WS_MOD);
    bf16_t* H2 = (bf16_t*)(a.ws + A_H2);
    unsigned* cnt = (unsigned*)(a.ws + WS_CTL) + CW_CNT + l * 16;
    int* LIST = (int*)(a.ws + A_LIST); float* TOKW = (float*)(a.ws + A_TOKW);
    const int nrows = need_ctx ? RT : RLAT;
    const int rp = (nrows + (int)gridDim.x - 1) / (int)gridDim.x;
    const int r0 = blockIdx.x * rp;
    for (int i = wave; i < rp; i += 8) {
        const int r = r0 + i;
        if (r >= nrows) { if (lane == 0) { se[i * 2] = -1; se[i * 2 + 1] = -1; } continue; }
        const float* xr = (r < RLAT) ? a.out + (size_t)r * D : (const float*)(a.ws + WS_XCTX) + (size_t)(r - RLAT) * D;
        f32x4 v[4], h[4];
#pragma unroll
        for (int j = 0; j < 4; ++j) v[j] = *(const f32x4*)(xr + 4 * lane + 256 * j);
        const float* m = MOD + ((size_t)l * 3 + row_mv(r)) * 6144;
        norm_mod_row(v, a.in[I_N2G] + l * D, m + 3072, m + 4096, H2 + (size_t)r * D, lane, h);
        int i1 = 0, i2 = 0; float c1 = 0.f, c2 = 0.f, bestv = -1e30f;
#pragma unroll 1
        for (int g = 0; g < 4; ++g) {
            float m1 = -1e30f, m2 = -1e30f, q1 = 0.f, q2 = 0.f; int j1 = 0, j2 = 0;
#pragma unroll
            for (int jj = 0; jj < 4; ++jj) {
                const int e = g * 4 + jj;
                float p = 0.f;
#pragma unroll
                for (int j = 0; j < 4; ++j) { const f32x4 w = *(const LAS f32x4*)(Wt + e * 1024 + 256 * j + 4 * lane); p += (h[j].x * w.x + h[j].y * w.y) + (h[j].z * w.z + h[j].w * w.w); }
                const float sc = sigmoidf_(wave_sum_dpp(p));
                const float x = sc + a.in[I_RTB][e];
                if (x > m1) { m2 = m1; j2 = j1; q2 = q1; m1 = x; j1 = e; q1 = sc; } else if (x > m2) { m2 = x; j2 = e; q2 = sc; }
            }
            const float gs = m1 + m2;
            if (gs > bestv) { bestv = gs; i1 = j1; i2 = j2; c1 = q1; c2 = q2; }
        }
        if (lane == 0) {
            const float inv = 1.0f / (c1 + c2);
            se[i * 2] = i1; se[i * 2 + 1] = i2;
            TOKW[(size_t)r * 2] = c1 * inv; TOKW[(size_t)r * 2 + 1] = c2 * inv;
        }
    }
    __syncthreads();
    if (tid < 16) {
        int c = 0;
        for (int i = 0; i < rp * 2; ++i) c += (se[i] == tid) ? 1 : 0;
        unsigned p = atomicAdd(cnt + tid, (unsigned)c);
        for (int i = 0; i < rp * 2; ++i) if (se[i] == tid) { LIST[(size_t)tid * RT + p] = (r0 + (i >> 1)) * 2 + (i & 1); ++p; }
    }
    __syncthreads();
}

__device__ __forceinline__ void moe_counts(const Args& a, int l, int (&cn)[16], int (&base)[16], int (&mtc)[17]) {
    const unsigned* cnt = (const unsigned*)(a.ws + WS_CTL) + CW_CNT + l * 16;
    int s = 0, t = 0;
#pragma unroll
    for (int e = 0; e < 16; ++e) { cn[e] = (int)__hip_atomic_load(cnt + e, __ATOMIC_RELAXED, __HIP_MEMORY_SCOPE_AGENT); base[e] = s; s += cn[e]; mtc[e] = t; t += (cn[e] + 127) >> 7; }
    mtc[16] = t;
}
__device__ __forceinline__ void phase_moe_up(const Args& a, int l, LAS unsigned char* lds, int tid, int lane, int wave) {
    LAS bf16_t* sm = (LAS bf16_t*)lds;
    int cn[16], base[16], mtc[17]; moe_counts(a, l, cn, base, mtc);
    const int* LIST = (const int*)(a.ws + A_LIST);
    const bf16_t* H2 = (const bf16_t*)(a.ws + A_H2);
    const bf16_t* WG = (const bf16_t*)(a.ws + A_WG); const bf16_t* WU = (const bf16_t*)(a.ws + A_WU);
    bf16_t* HID = (bf16_t*)(a.ws + A_HID);
    const int wm = wave >> 2, wn = wave & 3, fr = lane & 15, fq = lane >> 4;
    const int srow = tid >> 3, skc = tid & 7;
    const int ntile = mtc[16] * 4;
    for (int tile = blockIdx.x; tile < ntile; tile += gridDim.x) {
        const int mtg = tile >> 2, tn = tile & 3;
        int e = 0;
#pragma unroll
        for (int i = 1; i < 16; ++i) if (mtg >= mtc[i]) e = i;
        int cne = 0, be = 0, mt0 = 0;
#pragma unroll
        for (int i = 0; i < 16; ++i) if (i == e) { cne = cn[i]; be = base[i]; mt0 = mtc[i]; }
        const int m0 = (mtg - mt0) * 128;
        const int i0 = min(m0 + srow, cne - 1), i1 = min(m0 + srow + 64, cne - 1);
        const int tok0 = LIST[(size_t)e * RT + i0] >> 1, tok1 = LIST[(size_t)e * RT + i1] >> 1;
        const bf16_t* pa0 = H2 + (size_t)tok0 * D + skc * 8;
        const bf16_t* pa1 = H2 + (size_t)tok1 * D + skc * 8;
        f32x4 acc[4][2], acc2[4][2]; ZERO_ACC(acc); ZERO_ACC(acc2);
        {
            const bf16_t* pb0 = WG + ((size_t)e * DE + tn * 128 + srow) * D + skc * 8;
            gemm_tile(sm, pa0, pa1, pb0, pb0 + (size_t)64 * D, 16, acc, tid, lane, wm, wn);
        }
        {
            const bf16_t* pb0 = WU + ((size_t)e * DE + tn * 128 + srow) * D + skc * 8;
            gemm_tile(sm, pa0, pa1, pb0, pb0 + (size_t)64 * D, 16, acc2, tid, lane, wm, wn);
        }
#pragma unroll
        for (int mi = 0; mi < 4; ++mi) {
            const int li = m0 + wm * 64 + mi * 16 + fr;
            if (li < cne) {
#pragma unroll
                for (int ni = 0; ni < 2; ++ni) {
                    const int nc = tn * 128 + wn * 32 + ni * 16 + 4 * fq;
                    float o[4];
#pragma unroll
                    for (int j = 0; j < 4; ++j) o[j] = siluf_(acc[mi][ni][j]) * acc2[mi][ni][j];
                    u32x2 w; w.x = pk2(o[0], o[1]); w.y = pk2(o[2], o[3]);
                    *(u32x2*)(HID + (size_t)(be + li) * DE + nc) = w;
                }
            }
        }
    }
}
__device__ __forceinline__ void phase_moe_down(const Args& a, int l, LAS unsigned char* lds, int tid, int lane, int wave) {
    LAS bf16_t* sm = (LAS bf16_t*)lds;
    int cn[16], base[16], mtc[17]; moe_counts(a, l, cn, base, mtc);
    const int* LIST = (const int*)(a.ws + A_LIST); const float* TOKW = (const float*)(a.ws + A_TOKW);
    const bf16_t* HID = (const bf16_t*)(a.ws + A_HID); const bf16_t* WD = (const bf16_t*)(a.ws + A_WD);
    bf16_t* CON = (bf16_t*)(a.ws + A_CONTRIB);
    const int wm = wave >> 2, wn = wave & 3, fr = lane & 15, fq = lane >> 4;
    const int srow = tid >> 3, skc = tid & 7;
    const int ntile = mtc[16] * 8;
    for (int tile = blockIdx.x; tile < ntile; tile += gridDim.x) {
        const int mtg = tile >> 3, tn = tile & 7;
        int e = 0;
#pragma unroll
        for (int i = 1; i < 16; ++i) if (mtg >= mtc[i]) e = i;
        int cne = 0, be = 0, mt0 = 0;
#pragma unroll
        for (int i = 0; i < 16; ++i) if (i == e) { cne = cn[i]; be = base[i]; mt0 = mtc[i]; }
        const int m0 = (mtg - mt0) * 128;
        const int i0 = min(m0 + srow, cne - 1), i1 = min(m0 + srow + 64, cne - 1);
        const bf16_t* pa0 = HID + (size_t)(be + i0) * DE + skc * 8;
        const bf16_t* pa1 = HID + (size_t)(be + i1) * DE + skc * 8;
        const bf16_t* pb0 = WD + ((size_t)e * D + tn * 128 + srow) * DE + skc * 8;
        f32x4 acc[4][2]; ZERO_ACC(acc);
        gemm_tile(sm, pa0, pa1, pb0, pb0 + (size_t)64 * DE, 8, acc, tid, lane, wm, wn);
#pragma unroll
        for (int mi = 0; mi < 4; ++mi) {
            const int li = m0 + wm * 64 + mi * 16 + fr;
            if (li < cne) {
                const int ent = LIST[(size_t)e * RT + li];
                const float w = TOKW[ent];
                bf16_t* dst = CON + ((size_t)(ent & 1) * RT + (ent >> 1)) * D;
#pragma unroll
                for (int ni = 0; ni < 2; ++ni) {
                    const int nc = tn * 128 + wn * 32 + ni * 16 + 4 * fq;
                    u32x2 o; o.x = pk2(w * acc[mi][ni][0], w * acc[mi][ni][1]); o.y = pk2(w * acc[mi][ni][2], w * acc[mi][ni][3]);
                    *(u32x2*)(dst + nc) = o;
                }
            }
        }
    }
}
__device__ __forceinline__ void phase_combine(const Args& a, int l, bool need_ctx, bool last, int lane, int gw, int nw) {
    const float* MOD = (const float*)(a.ws + WS_MOD);
    const bf16_t* CON = (const bf16_t*)(a.ws + A_CONTRIB);
    bf16_t* H = (bf16_t*)(a.ws + A_H);
    const int nrows = need_ctx ? RT : RLAT;
    for (int r = gw; r < nrows; r += nw) {
        float* xr = xrow_out(a, r);
        const float* g2 = MOD + ((size_t)l * 3 + row_mv(r)) * 6144 + 5120;
        f32x4 v[4];
#pragma unroll
        for (int j = 0; j < 4; ++j) {
            const int idx = 4 * lane + 256 * j;
            v[j] = *(const f32x4*)(xr + idx);
            float c0[4], c1[4];
            unpack4(*(const u32x2*)(CON + (size_t)r * D + idx), c0); unpack4(*(const u32x2*)(CON + ((size_t)RT + r) * D + idx), c1);
            const f32x4 g = *(const f32x4*)(g2 + idx);
            v[j].x += g.x * (c0[0] + c1[0]); v[j].y += g.y * (c0[1] + c1[1]); v[j].z += g.z * (c0[2] + c1[2]); v[j].w += g.w * (c0[3] + c1[3]);
        }
        if (!last) {
#pragma unroll
            for (int j = 0; j < 4; ++j) *(f32x4*)(xr + 4 * lane + 256 * j) = v[j];
            f32x4 h[4];
            const float* m = MOD + ((size_t)(l + 1) * 3 + row_mv(r)) * 6144;
            norm_mod_row(v, a.in[I_N1G] + (l + 1) * D, m, m + 1024, H + (size_t)r * D, lane, h);
        } else {
            float s = 0.f;
#pragma unroll
            for (int j = 0; j < 4; ++j) s += (v[j].x * v[j].x + v[j].y * v[j].y) + (v[j].z * v[j].z + v[j].w * v[j].w);
            s = wave_sum_shfl(s);
            const float rstd = rsqrtf(s * (1.0f / D) + NORM_EPS);
#pragma unroll
            for (int j = 0; j < 4; ++j) {
                const int idx = 4 * lane + 256 * j;
                const f32x4 g = *(const f32x4*)(a.in[I_FG] + idx);
                f32x4 o; o.x = v[j].x * rstd * g.x; o.y = v[j].y * rstd * g.y; o.z = v[j].z * rstd * g.z; o.w = v[j].w * rstd * g.w;
                *(f32x4*)(xr + idx) = o;
            }
        }
    }
}

__global__ void __launch_bounds__(512) mega(Args a_in) {
    extern __shared__ __attribute__((aligned(16))) unsigned char lds_raw[];
    LAS unsigned char* lds = (LAS unsigned char*)lds_raw;
    volatile LAS unsigned* misc = (volatile LAS unsigned*)(lds + LDS_MISC);
    if (threadIdx.x < 64) misc[threadIdx.x] = 0u;
    __syncthreads();
    const bool multi = (a_in.ph_hi - a_in.ph_lo) > 1;
    XcdBarrier bar; bar.bar = (unsigned*)(a_in.ws + WS_CTL) + CW_BAR; bar.x = 0; bar.st = misc;
    if (multi) bar = xcd_barrier_post((unsigned*)(a_in.ws + WS_CTL) + CW_BAR, misc);

    const Args& a0 = a_in;
    for (int ph = a0.ph_lo; ph < a0.ph_hi; ++ph) {
        Args a = a0;
        { unsigned long long w_ = (unsigned long long)a.ws; asm volatile("" : "+s"(w_)); a.ws = (unsigned char*)w_; }
        { unsigned long long w_ = (unsigned long long)a.out; asm volatile("" : "+s"(w_)); a.out = (float*)w_; }
        int tid = threadIdx.x; asm volatile("" : "+v"(tid));
        const int lane = tid & 63, wave = __builtin_amdgcn_readfirstlane(tid >> 6);
        const int gw = blockIdx.x * 8 + wave, nw = gridDim.x * 8;
        if (ph == 0 && SUB_ON(100)) {
            REP(100) { phase_mod(a, lds, tid, lane, wave);
            for (int it = gw; it < CONV_CORE_ITEMS; it += nw) conv_core(a, 0, it, lane); }
        } else if (ph == 1 && SUB_ON(101)) {
            phase_norm1(a, 0, lane, gw, nw);
        } else if (ph >= 2) {
            const int l = (ph - 2) / 13, sub = (ph - 2) % 13;
            const bool last = (l == 1), need_ctx = !last;
            switch (sub) {
            case 0: if (!SUB_ON(0)) break; REP(0) phase_inproj(a, lds, tid, lane, wave); break;
            case 1: if (!SUB_ON(1)) break; REP(1) phase_ml_a(a, l, lds, tid, lane, wave); break;
            case 2: if (!SUB_ON(2)) break; phase_ml_b(a, tid); break;
            case 3: if (!SUB_ON(3)) break; REP(3) phase_ml_c(a, l, need_ctx, lds, tid, lane, wave); break;
            case 4: if (!SUB_ON(4)) break; REP(4) phase_rw_a(a, l, lds, tid, lane, wave); break;
            case 5: if (!SUB_ON(5)) break; phase_rw_b(a, lane, blockIdx.x + (int)gridDim.x * wave); break;
            case 6: if (!SUB_ON(6)) break; REP(6) phase_rw_c(a, l, need_ctx, lds, tid, lane, wave); break;
            case 7: if (!SUB_ON(7)) break; REP(7) phase_merge1(a, need_ctx, lds, tid, lane, wave); break;
            case 8: if (!SUB_ON(8)) break; phase_merge2(a, l, need_ctx, lds, tid, lane, wave);
                    for (int it = gw; it < CONV_EXP_ITEMS; it += nw) conv_exp(a, l, it, lane);
                    break;
            case 9: if (!SUB_ON(9)) break; phase_router(a, l, need_ctx, lds, tid, lane, wave); break;
            case 10: if (!SUB_ON(10)) break; REP(10) phase_moe_up(a, l, lds, tid, lane, wave); break;
            case 11: if (!SUB_ON(11)) break; REP(11) phase_moe_down(a, l, lds, tid, lane, wave); break;
            default: if (!SUB_ON(12)) break; phase_combine(a, l, need_ctx, last, lane, gw, nw);
                     if (!last) for (int it = gw; it < CONV_CORE_ITEMS; it += nw) conv_core(a, l + 1, it, lane);
                     break;
            }
        }
        if (ph + 1 < a0.ph_hi) { xcd_barrier(bar); if (PROBE_SUB == 99) xcd_barrier(bar); }
    }
}
}

extern "C" void kernel_launch(void* const* d_in, const int* in_sizes, int n_in, void* d_out, int out_size, void* d_ws, size_t ws_size, hipStream_t stream) {
    static int grid = 0;
    if (grid == 0) {
        if (n_in != 33 || in_sizes[0] != RLAT * D || out_size != RLAT * D || ws_size < WS_NEED) {
            fprintf(stderr, "kernel_launch: unexpected shapes / workspace: n_in %d in0 %d out %d ws %zu (need %zu)\n", n_in, n_in > 0 ? in_sizes[0] : -1, out_size, ws_size, (size_t)WS_NEED);
            grid = -1; return;
        }
        int dev = 0, cus = 0;
        if (hipGetDevice(&dev) != hipSuccess || hipDeviceGetAttribute(&cus, hipDeviceAttributeMultiprocessorCount, dev) != hipSuccess) { grid = -1; return; }
        if (hipFuncSetAttribute((const void*)mega, hipFuncAttributeMaxDynamicSharedMemorySize, LDS_BYTES) != hipSuccess) { fprintf(stderr, "kernel_launch: hipFuncSetAttribute failed\n"); grid = -1; return; }
        (void)hipGetLastError();
        grid = cus;
    }
    if (grid < 0) return;
    (void)hipMemsetAsync((char*)d_ws + WS_CTL, 0, CTL_BYTES, stream);
    Args a{};
    for (int i = 0; i < 33; ++i) a.in[i] = (const float*)d_in[i];
    a.out = (float*)d_out; a.ws = (unsigned char*)d_ws;
#if MK_PER_PHASE
    for (int ph = 0; ph < NPHASE; ++ph) { a.ph_lo = ph; a.ph_hi = ph + 1; hipLaunchKernelGGL(mega, dim3(grid), dim3(512), LDS_BYTES, stream, a); }
#else
    a.ph_lo = 0; a.ph_hi = NPHASE;
    hipLaunchKernelGGL(mega, dim3(grid), dim3(512), LDS_BYTES, stream, a);
#endif
}
```
